# Optimizing an MI355X kernel written in HIP

```python
import jax, jax.numpy as jnp
from jax import lax
import numpy as np

D_MODEL = 1024
BATCH = 8
SEQ = 2048
DEPTH = 4

MIX_WIDTH = D_MODEL
A_HEADS = 4
A_DV = MIX_WIDTH // 2 // A_HEADS
A_DK = A_DV // 2
B_HEADS = 4
B_DV = MIX_WIDTH // 2 // B_HEADS
B_DK = B_DV // 2
A_QK = A_HEADS * A_DK
A_V = A_HEADS * A_DV
B_QK = B_HEADS * B_DK
B_V = B_HEADS * B_DV
GLA_RANK = 16
GLA_GATE_TEMP = 16.0
CONV_W = 3
D_FF = 2816
CHUNK = 64
EPS = 1e-6
IN_WIDTHS = (2 * A_QK, A_V, A_V, 4 * A_HEADS, B_QK, B_QK, B_V, B_V, 2 * GLA_RANK)
IN_COLS = 2 * A_QK + A_V + A_V + 4 * A_HEADS + B_QK + B_QK + B_V + B_V + 2 * GLA_RANK

kernel_name = "hybrid_mlstm_gla_convffn_encoder"


def rms_norm(x, g):
    xf = x.astype(jnp.float32)
    y = xf * lax.rsqrt(jnp.mean(xf * xf, axis=-1, keepdims=True) + EPS)
    return (y * g.astype(jnp.float32)).astype(x.dtype)


def head_rms_norm(y, g):
    y = y * lax.rsqrt(jnp.mean(y * y, axis=-1, keepdims=True) + EPS)
    return y * g.astype(jnp.float32)


def dwconv3(x, w, b):
    xp = jnp.pad(x, ((0, 0), (1, 1), (0, 0)))
    return xp[:, :-2] * w[0] + xp[:, 1:-1] * w[1] + xp[:, 2:] * w[2] + b


def flip(t):
    return t[:, ::-1]


def to_chunks(t):
    b, s, h = t.shape[:3]
    t = t.reshape((b, s // CHUNK, CHUNK, h) + t.shape[3:])
    return jnp.moveaxis(t, (1, 3), (0, 2))


def from_chunks(y):
    y = jnp.moveaxis(y, (0, 2), (1, 3))
    b, nc, l, h, d = y.shape
    return y.reshape(b, nc * l, h, d)


def mlstm_chunkwise(q, k, v, i_pre, log_f):
    bsz, _, h, dk = q.shape
    dv = v.shape[-1]
    causal = jnp.tril(jnp.ones((CHUNK, CHUNK), dtype=bool))

    def step(carry, inp):
        c_st, n_st, m_st = carry
        q_, k_, v_, i_, f_ = inp
        b = jnp.cumsum(f_, axis=-1)
        d_intra = jnp.where(causal, b[..., :, None] - b[..., None, :] + i_[..., None, :], -jnp.inf)
        m_inter = b + m_st[..., None]
        m_t = jnp.maximum(m_inter, jnp.max(d_intra, axis=-1))
        s = jnp.einsum('bhtd,bhsd->bhts', q_, k_) * jnp.exp(d_intra - m_t[..., None])
        inter = jnp.exp(m_inter - m_t)
        num = jnp.einsum('bhts,bhse->bhte', s, v_) + inter[..., None] * jnp.einsum('bhtd,bhde->bhte', q_, c_st)
        den = jnp.sum(s, axis=-1) + inter * jnp.einsum('bhtd,bhd->bht', q_, n_st)
        h_out = num / jnp.maximum(jnp.abs(den), jnp.exp(-m_t))[..., None]
        b_last = b[..., -1]
        g = b_last[..., None] - b + i_
        m_new = jnp.maximum(b_last + m_st, jnp.max(g, axis=-1))
        decay = jnp.exp(b_last + m_st - m_new)
        wk = jnp.exp(g - m_new[..., None])[..., None] * k_
        c_new = decay[..., None, None] * c_st + jnp.einsum('bhsd,bhse->bhde', wk, v_)
        n_new = decay[..., None] * n_st + jnp.sum(wk, axis=-2)
        return (c_new, n_new, m_new), h_out

    init = (jnp.zeros((bsz, h, dk, dv), jnp.float32),
            jnp.zeros((bsz, h, dk), jnp.float32),
            jnp.zeros((bsz, h), jnp.float32))
    _, hs = lax.scan(step, init, (to_chunks(q), to_chunks(k), to_chunks(v),
                                  to_chunks(i_pre), to_chunks(log_f)))
    return from_chunks(hs)


def gla_chunkwise(q, k, v, log_a):
    bsz, _, h, dk = q.shape
    dv = v.shape[-1]
    causal = jnp.tril(jnp.ones((CHUNK, CHUNK), dtype=bool))[..., None]

    def step(s_st, inp):
        q_, k_, v_, a_ = inp
        b = jnp.cumsum(a_, axis=-2)
        diff = b[..., :, None, :] - b[..., None, :, :]
        decay = jnp.exp(jnp.where(causal, diff, -jnp.inf))
        s = jnp.einsum('bhtd,bhsd,bhtsd->bhts', q_, k_, decay)
        o = jnp.einsum('bhts,bhse->bhte', s, v_) + jnp.einsum('bhtd,bhde->bhte', q_ * jnp.exp(b), s_st)
        b_last = b[..., -1:, :]
        k_dec = k_ * jnp.exp(b_last - b)
        s_new = jnp.exp(b_last[..., 0, :])[..., None] * s_st + jnp.einsum('bhsd,bhse->bhde', k_dec, v_)
        return s_new, o

    init = jnp.zeros((bsz, h, dk, dv), jnp.float32)
    _, os_ = lax.scan(step, init, (to_chunks(q), to_chunks(k), to_chunks(v), to_chunks(log_a)))
    return from_chunks(os_)


def hybrid_mixer(hn, w_in, mlstm_gate_b, mlstm_conv_w, mlstm_conv_b, mlstm_norm,
                 gla_w2, gla_b, gla_norm, w_out):
    bsz, s, _ = hn.shape
    proj = jnp.matmul(hn, w_in).astype(jnp.float32)
    idx = np.cumsum(np.array(IN_WIDTHS))[:-1].tolist()
    a_qk, a_v, a_o, a_gates, b_q, b_k, b_v, b_r, b_lr = jnp.split(proj, idx, axis=-1)

    qk = jax.nn.silu(dwconv3(a_qk, mlstm_conv_w.astype(jnp.float32), mlstm_conv_b.astype(jnp.float32)))
    q_a = qk[..., :A_QK].reshape(bsz, s, A_HEADS, A_DK)
    k_a = qk[..., A_QK:].reshape(bsz, s, A_HEADS, A_DK) * (A_DK ** -0.5)
    v_a = a_v.reshape(bsz, s, A_HEADS, A_DV)
    gates = a_gates + mlstm_gate_b.astype(jnp.float32)
    i_fw, f_fw, i_bw, f_bw = jnp.split(gates, 4, axis=-1)
    h_fw = mlstm_chunkwise(q_a, k_a, v_a, i_fw, jax.nn.log_sigmoid(f_fw))
    h_bw = flip(mlstm_chunkwise(flip(q_a), flip(k_a), flip(v_a), flip(i_bw), flip(jax.nn.log_sigmoid(f_bw))))
    y_a = jax.nn.sigmoid(a_o) * head_rms_norm(h_fw + h_bw, mlstm_norm).reshape(bsz, s, A_V)

    q_b = b_q.reshape(bsz, s, B_HEADS, B_DK) * (B_DK ** -0.5)
    k_b = b_k.reshape(bsz, s, B_HEADS, B_DK)
    v_b = b_v.reshape(bsz, s, B_HEADS, B_DV)
    lr_fw, lr_bw = jnp.split(b_lr, 2, axis=-1)
    w2 = gla_w2.astype(jnp.float32)
    gb = gla_b.astype(jnp.float32)
    la_fw = (jax.nn.log_sigmoid(lr_fw @ w2[0] + gb[0]) / GLA_GATE_TEMP).reshape(bsz, s, B_HEADS, B_DK)
    la_bw = (jax.nn.log_sigmoid(lr_bw @ w2[1] + gb[1]) / GLA_GATE_TEMP).reshape(bsz, s, B_HEADS, B_DK)
    o_fw = gla_chunkwise(q_b, k_b, v_b, la_fw)
    o_bw = flip(gla_chunkwise(flip(q_b), flip(k_b), flip(v_b), flip(la_bw)))
    y_b = jax.nn.silu(b_r) * head_rms_norm(o_fw + o_bw, gla_norm).reshape(bsz, s, B_V)

    y = jnp.concatenate([y_a, y_b], axis=-1).astype(hn.dtype)
    return jnp.matmul(y, w_out)


def conv_ffn(hn, w_gate, w_up, conv_w, conv_b, w_down):
    g = dwconv3(jnp.matmul(hn, w_gate), conv_w, conv_b)
    u = jnp.matmul(hn, w_up)
    return jnp.matmul(jax.nn.gelu(g, approximate=True) * u, w_down)


def setup_inputs(seed: int = 0) -> dict:
    key = jax.random.key(seed)
    ks = jax.random.split(key, 20)
    f32 = jnp.float32

    def nrm(k, shape, scale):
        return jax.random.normal(k, shape, f32) * scale

    def gain(k, shape):
        return 1.0 + 0.05 * jax.random.normal(k, shape, f32)

    f_base = jnp.linspace(3.0, 6.0, A_HEADS, dtype=f32)
    i_base = jnp.zeros((A_HEADS,), f32)
    gate_base = jnp.concatenate([i_base, f_base, i_base, f_base])
    return {
        "x": nrm(ks[0], (BATCH, SEQ, D_MODEL), 1.0),
        "norm_mix_pre": gain(ks[1], (DEPTH, D_MODEL)),
        "norm_mix_post": gain(ks[2], (DEPTH, D_MODEL)),
        "norm_ffn_pre": gain(ks[3], (DEPTH, D_MODEL)),
        "norm_ffn_post": gain(ks[4], (DEPTH, D_MODEL)),
        "w_in": nrm(ks[5], (DEPTH, D_MODEL, IN_COLS), D_MODEL ** -0.5),
        "mlstm_gate_b": gate_base + nrm(ks[6], (DEPTH, 4 * A_HEADS), 0.1),
        "mlstm_conv_w": nrm(ks[7], (DEPTH, CONV_W, 2 * A_QK), CONV_W ** -0.5),
        "mlstm_conv_b": nrm(ks[8], (DEPTH, 2 * A_QK), 0.02),
        "mlstm_norm": gain(ks[9], (DEPTH, A_HEADS, A_DV)),
        "gla_w2": nrm(ks[10], (DEPTH, 2, GLA_RANK, B_QK), GLA_RANK ** -0.5),
        "gla_b": nrm(ks[11], (DEPTH, 2, B_QK), 0.02),
        "gla_norm": gain(ks[12], (DEPTH, B_HEADS, B_DV)),
        "w_out": nrm(ks[13], (DEPTH, MIX_WIDTH, D_MODEL), MIX_WIDTH ** -0.5),
        "ffn_w_gate": nrm(ks[14], (DEPTH, D_MODEL, D_FF), D_MODEL ** -0.5),
        "ffn_w_up": nrm(ks[15], (DEPTH, D_MODEL, D_FF), D_MODEL ** -0.5),
        "ffn_conv_w": nrm(ks[16], (DEPTH, CONV_W, D_FF), CONV_W ** -0.5),
        "ffn_conv_b": nrm(ks[17], (DEPTH, D_FF), 0.02),
        "ffn_w_down": nrm(ks[18], (DEPTH, D_FF, D_MODEL), D_FF ** -0.5),
    }


def reference(x, norm_mix_pre, norm_mix_post, norm_ffn_pre, norm_ffn_post, w_in,
              mlstm_gate_b, mlstm_conv_w, mlstm_conv_b, mlstm_norm, gla_w2, gla_b, gla_norm,
              w_out, ffn_w_gate, ffn_w_up, ffn_conv_w, ffn_conv_b, ffn_w_down):
    for l in range(DEPTH):
        hn = rms_norm(x, norm_mix_pre[l])
        mix = hybrid_mixer(hn, w_in[l], mlstm_gate_b[l], mlstm_conv_w[l], mlstm_conv_b[l], mlstm_norm[l],
                           gla_w2[l], gla_b[l], gla_norm[l], w_out[l])
        x = x + rms_norm(mix, norm_mix_post[l])
        hn = rms_norm(x, norm_ffn_pre[l])
        ff = conv_ffn(hn, ffn_w_gate[l], ffn_w_up[l], ffn_conv_w[l], ffn_conv_b[l], ffn_w_down[l])
        x = x + rms_norm(ff, norm_ffn_post[l])
    return x
```

```cpp
#include <hip/hip_runtime.h>
#include <cstdio>
#include <cstdint>
namespace pg8 {
#define PG8_LAS __attribute__((address_space(3)))
typedef unsigned short bf16_t;
typedef short bf16x8 __attribute__((ext_vector_type(8)));
typedef float f32x4 __attribute__((ext_vector_type(4)));
typedef unsigned u32x4 __attribute__((ext_vector_type(4)));
constexpr int BM = 256, BK = 64, HALF = 128, HTB = HALF * BK * 2  , STAGE_BYTES = 8 * HTB, NXCD = 8, WGM = 8;

__host__ __device__ __forceinline__ int lds_byte(int r, int c) { const int st = (r >> 4) * 2 + (c >> 5), rr = r & 15, cc = c & 31, ob = rr * 64 + cc * 2; return st * 1024 + (ob ^ (((ob >> 9) & 1) << 5)); }
__host__ __device__ __forceinline__ void stage_rc(int b, int& R, int& C) { const int st = b / 1024, sb = b % 1024, swz = sb ^ (((sb >> 9) & 1) << 5); R = (st >> 1) * 16 + swz / 64; C = (st & 1) * 32 + (swz % 64) / 2; }
__host__ __device__ __forceinline__ int perm32(int rho) { const int n = rho >> 4, i = rho & 15; return 8 * (i >> 2) + 4 * n + (i & 3); }

struct Unit { int pm, pn; };
struct Gemm { const bf16_t* A; const bf16_t* Bt; int M, N, K; };

struct StaticOrder {
    int nM, nN, nwg, G, c;
    __host__ __device__ void init(int M, int N, int G_, int c_) { nM = M / BM; nN = N / BM; nwg = nM * nN; G = G_; c = c_; }
    __host__ __device__ bool next(int i, Unit& u) const {
        const long L = (long)i * G + c; if (L >= nwg) return false;
        int wgid = (int)L; { const int q = nwg / NXCD, r = nwg % NXCD, xcd = wgid % NXCD, off = wgid / NXCD; wgid = (xcd < r ? xcd * (q + 1) : r * (q + 1) + (xcd - r) * q) + off; }
        const int nig = WGM * nN, gid = wgid / nig, fm = gid * WGM, gsz = (nM - fm) < WGM ? (nM - fm) : WGM;
        u.pm = fm + ((wgid % nig) % gsz); u.pn = (wgid % nig) / gsz; return true;
    }
    __device__ __forceinline__ void a_ready(const Unit&) const {}
    __device__ __forceinline__ void done(const Unit&) const {}
};

__device__ __forceinline__ unsigned cvt_pk_bf16(float lo, float hi) { unsigned r; asm volatile("v_cvt_pk_bf16_f32 %0, %1, %2" : "=v"(r) : "v"(lo), "v"(hi)); return r; }
typedef float f32x2 __attribute__((ext_vector_type(2)));
__device__ __forceinline__ f32x2 gelu_pk(f32x2 v) {
    const f32x2 av = __builtin_elementwise_abs(v), d = av * 0.2316418882f + 1.0f;
    f32x2 t; t.x = __builtin_amdgcn_rcpf(d.x); t.y = __builtin_amdgcn_rcpf(d.y);
    f32x2 q = t * 0.5307027145f + (-0.7265760135f); q = q * t + 0.7107068705f; q = q * t + (-0.142248368f); q = q * t + 0.127414796f; q = q * t;
    const f32x2 s = (v * v) * (-0.72134752044f);
    f32x2 e; e.x = __builtin_amdgcn_exp2f(s.x); e.y = __builtin_amdgcn_exp2f(s.y);
    const f32x2 m = v * (q * e), r = v - m;
    f32x2 o; o.x = v.x < 0.f ? m.x : r.x; o.y = v.y < 0.f ? m.y : r.y; return o;
}

template <int ACT  > struct EpiBf16 {
    static constexpr bool PERM = true, AFTER_DRAIN = false; static_assert(ACT == 0 || ACT == 1, "EpiBf16: ACT is 0 (none) or 1 (gelu_pk)");
    bf16_t* O; int ldc; const float* bias; int split_cols; size_t split_stride; float scale0;
    __device__ __forceinline__ void operator()(const f32x4 (&acc)[2][2][4][2], const Unit& u, int wr, int wc, int fr, int fq) const {
        const int row0 = u.pm * BM + wr * 64 + fr; int colt = u.pn * BM; bf16_t* base = O;
        float sc = 1.f; if (split_cols) { const int t = colt / split_cols; base += (size_t)t * split_stride; colt -= t * split_cols; if (t == 0) sc = scale0; }
        const int col0 = colt + wc * 32 + 8 * fq, bcol0 = u.pn * BM + wc * 32 + 8 * fq;
        f32x4 bv[2][2];
#pragma unroll
        for (int bj = 0; bj < 2; ++bj)
#pragma unroll
            for (int n = 0; n < 2; ++n) bv[bj][n] = bias ? *(const f32x4*)(bias + bcol0 + bj * HALF + 4 * n) : (f32x4){0.f, 0.f, 0.f, 0.f};
#pragma unroll
        for (int ai = 0; ai < 2; ++ai)
#pragma unroll
            for (int m = 0; m < 4; ++m) { bf16_t* rowp = base + (size_t)(row0 + ai * HALF + m * 16) * ldc + col0;
#pragma unroll
                for (int bj = 0; bj < 2; ++bj) { f32x4 v0 = acc[ai][bj][m][0] + bv[bj][0], v1 = acc[ai][bj][m][1] + bv[bj][1];
                    if (ACT == 1) { f32x2 a = gelu_pk((f32x2){v0[0], v0[1]}), b = gelu_pk((f32x2){v0[2], v0[3]}), c = gelu_pk((f32x2){v1[0], v1[1]}), d = gelu_pk((f32x2){v1[2], v1[3]});
                        v0 = (f32x4){a.x, a.y, b.x, b.y}; v1 = (f32x4){c.x, c.y, d.x, d.y}; }
                    v0 = v0 * sc; v1 = v1 * sc; u32x4 w; w.x = cvt_pk_bf16(v0[0], v0[1]); w.y = cvt_pk_bf16(v0[2], v0[3]); w.z = cvt_pk_bf16(v1[0], v1[1]); w.w = cvt_pk_bf16(v1[2], v1[3]);
                    *(u32x4*)(rowp + bj * HALF) = w; } }
    }
};
struct EpiF32 {
    static constexpr bool PERM = false, AFTER_DRAIN = false;
    float* C; int ldc; const float* bias;
    __device__ __forceinline__ void operator()(const f32x4 (&acc)[2][2][4][2], const Unit& u, int wr, int wc, int fr, int fq) const {
        const int row0 = u.pm * BM + wr * 64 + fr, col0 = u.pn * BM + wc * 32 + 4 * fq;
        f32x4 bv[2][2];
#pragma unroll
        for (int bj = 0; bj < 2; ++bj)
#pragma unroll
            for (int n = 0; n < 2; ++n) bv[bj][n] = bias ? *(const f32x4*)(bias + col0 + bj * HALF + n * 16) : (f32x4){0.f, 0.f, 0.f, 0.f};
#pragma unroll
        for (int ai = 0; ai < 2; ++ai)
#pragma unroll
            for (int m = 0; m < 4; ++m) { float* rowp = C + (size_t)(row0 + ai * HALF + m * 16) * ldc + col0;
#pragma unroll
                for (int bj = 0; bj < 2; ++bj)
#pragma unroll
                    for (int n = 0; n < 2; ++n) *(f32x4*)(rowp + bj * HALF + n * 16) = acc[ai][bj][m][n] + bv[bj][n]; }
    }
};
template <class Epi, class Sched, bool ALIGN_EPI = false, bool SP2 = false>
__device__ __forceinline__ void gemm_phase(PG8_LAS unsigned char* lds, const Gemm g, const Sched& S, const Epi& E) {
    const int tid = threadIdx.x, wid = __builtin_amdgcn_readfirstlane(tid >> 6), lane = tid & 63, wr = wid >> 2, wc = wid & 3, fr = lane & 15, fq = lane >> 4;
    const int K = g.K, nt = K / BK;
    unsigned voffA[2], voffB[2];
#pragma unroll
    for (int i = 0; i < 2; ++i) { int R, C; stage_rc(tid * 16 + i * 8192, R, C); const int Rb = Epi::PERM ? ((R & ~31) + perm32(R & 31)) : R;
        voffA[i] = (unsigned)(R * K + C) * 2u; voffB[i] = (unsigned)(Rb * K + C) * 2u; }
    const size_t kstep = (size_t)(BK * 2);
    const size_t hstep = (size_t)HALF * K * 2;
    const size_t tstep = 2 * hstep;
    const unsigned ldsw = (unsigned)wid * 1024u;
    const int aoff = lds_byte(wr * 64 + fr, fq * 8), boff = lds_byte(wc * 32 + fr, fq * 8);
#define PG8_SA(b, h) (((b) * 2 + (h)) * HTB)
#define PG8_SB(b, h) ((4 + (b) * 2 + (h)) * HTB)
#define PG8_STAGE(bufoff, gbase, voff) do { _Pragma("unroll") for (int _i = 0; _i < 2; ++_i) \
        __builtin_amdgcn_global_load_lds((const unsigned*)((const char*)(gbase) + (voff)[_i]), (PG8_LAS unsigned*)(lds + (bufoff) + ldsw + _i * 8192), 16, 0, 0); } while (0)
#define PG8_LDA(dst, b, h) do { _Pragma("unroll") for (int m = 0; m < 4; ++m) _Pragma("unroll") for (int k = 0; k < 2; ++k) dst[m][k] = *(const PG8_LAS bf16x8*)(lds + PG8_SA(b, h) + aoff + m * 2048 + k * 1024); } while (0)
#define PG8_LDB(dst, b, h) do { _Pragma("unroll") for (int n = 0; n < 2; ++n) _Pragma("unroll") for (int k = 0; k < 2; ++k) dst[n][k] = *(const PG8_LAS bf16x8*)(lds + PG8_SB(b, h) + boff + n * 2048 + k * 1024); } while (0)
#define PG8_MMA(ai, bj, At, Bt) do { __builtin_amdgcn_s_setprio(1); _Pragma("unroll") for (int m = 0; m < 4; ++m) _Pragma("unroll") for (int n = 0; n < 2; ++n) _Pragma("unroll") for (int k = 0; k < 2; ++k) \
        acc[ai][bj][m][n] = __builtin_amdgcn_mfma_f32_16x16x32_bf16(Bt[n][k], At[m][k], acc[ai][bj][m][n], 0, 0, 0); __builtin_amdgcn_s_setprio(0); } while (0)
#define PG8_WAIT_V(n) asm volatile("s_waitcnt vmcnt(" #n ")" ::: "memory")
#define PG8_WAIT_L(n) asm volatile("s_waitcnt lgkmcnt(" #n ")" ::: "memory")
#define PG8_BAR __builtin_amdgcn_s_barrier()
#define PG8_SCHED __builtin_amdgcn_sched_barrier(0)
    Unit cur, nxt; int ui = 0;
    if (!S.next(0, cur)) return;
    f32x4 acc[2][2][4][2];
#pragma unroll
    for (int a = 0; a < 2; ++a)
#pragma unroll
        for (int b = 0; b < 2; ++b)
#pragma unroll
            for (int m = 0; m < 4; ++m)
#pragma unroll
                for (int n = 0; n < 2; ++n) acc[a][b][m][n] = (f32x4){0.f, 0.f, 0.f, 0.f};
    bf16x8 At[4][2], B0[2][2], B1[2][2];
    const char* cA = (const char*)g.A + (size_t)cur.pm * tstep; const char* cB = (const char*)g.Bt + (size_t)cur.pn * tstep;
    S.a_ready(cur);
    if constexpr (SP2) {
        PG8_STAGE(PG8_SB(0, 0), cB, voffB); PG8_STAGE(PG8_SB(0, 1), cB + hstep, voffB); PG8_STAGE(PG8_SA(0, 0), cA, voffA); PG8_STAGE(PG8_SA(0, 1), cA + hstep, voffA);
        if (wr == 1) PG8_BAR;
        PG8_WAIT_V(2); PG8_BAR;
        PG8_STAGE(PG8_SB(1, 0), cB + kstep, voffB); PG8_STAGE(PG8_SA(1, 0), cA + kstep, voffA); PG8_STAGE(PG8_SB(1, 1), cB + hstep + kstep, voffB);
        PG8_WAIT_V(6); PG8_BAR;
    } else {
        PG8_STAGE(PG8_SB(0, 0), cB, voffB); PG8_STAGE(PG8_SA(0, 0), cA, voffA); PG8_STAGE(PG8_SB(0, 1), cB + hstep, voffB); PG8_STAGE(PG8_SA(0, 1), cA + hstep, voffA);
        if (wr == 1) PG8_BAR;
        PG8_WAIT_V(4); PG8_BAR;
        PG8_STAGE(PG8_SB(1, 0), cB + kstep, voffB); PG8_STAGE(PG8_SA(1, 0), cA + kstep, voffA); PG8_STAGE(PG8_SB(1, 1), cB + hstep + kstep, voffB);
        PG8_WAIT_V(6); PG8_BAR;
    }
    for (;;) {
        const bool has_next = S.next(ui + 1, nxt);
        const char* nA = has_next ? (const char*)g.A + (size_t)nxt.pm * tstep : cA; const char* nB = has_next ? (const char*)g.Bt + (size_t)nxt.pn * tstep : cB;
        for (int t = 0; t < nt; t += 2) {
            const bool last = (t == nt - 2);
            const char* a1 = cA + (size_t)(t + 1) * kstep;
            const char* a2 = last ? nA : cA + (size_t)(t + 2) * kstep; const char* b2 = last ? nB : cB + (size_t)(t + 2) * kstep;
            const char* a3 = a2 + kstep; const char* b3 = b2 + kstep;
            if (last && has_next) S.a_ready(nxt);
            if constexpr (SP2) {
            PG8_LDB(B0, 0, 0); PG8_LDB(B1, 0, 1); PG8_SCHED; PG8_LDA(At, 0, 0); PG8_STAGE(PG8_SA(1, 1), a1 + hstep, voffA);
            PG8_WAIT_V(8); PG8_WAIT_L(0); PG8_BAR; PG8_MMA(0, 0, At, B0); PG8_MMA(0, 1, At, B1); PG8_BAR; PG8_SCHED;
            PG8_LDA(At, 0, 1); PG8_STAGE(PG8_SB(0, 0), b2, voffB); PG8_STAGE(PG8_SB(0, 1), b2 + hstep, voffB); PG8_STAGE(PG8_SA(0, 0), a2, voffA);
            PG8_WAIT_V(8); PG8_WAIT_L(0); PG8_BAR; PG8_MMA(1, 0, At, B0); PG8_MMA(1, 1, At, B1); PG8_BAR; PG8_SCHED;
            PG8_LDB(B0, 1, 0); PG8_LDB(B1, 1, 1); PG8_SCHED; PG8_LDA(At, 1, 0); PG8_STAGE(PG8_SA(0, 1), a2 + hstep, voffA);
            PG8_WAIT_V(8); PG8_WAIT_L(0); PG8_BAR; PG8_MMA(0, 0, At, B0); PG8_MMA(0, 1, At, B1); PG8_BAR; PG8_SCHED;
            PG8_LDA(At, 1, 1); PG8_STAGE(PG8_SB(1, 0), b3, voffB); PG8_STAGE(PG8_SB(1, 1), b3 + hstep, voffB); PG8_STAGE(PG8_SA(1, 0), a3, voffA);
            PG8_WAIT_V(8); PG8_WAIT_L(0); PG8_BAR; PG8_MMA(1, 0, At, B0); PG8_MMA(1, 1, At, B1); PG8_BAR; PG8_SCHED;
            } else {
            PG8_LDB(B0, 0, 0); PG8_SCHED; PG8_LDA(At, 0, 0); PG8_STAGE(PG8_SA(1, 1), a1 + hstep, voffA);
            PG8_WAIT_L(8); PG8_BAR; PG8_WAIT_L(0); PG8_MMA(0, 0, At, B0); PG8_BAR; PG8_SCHED;
            PG8_LDB(B1, 0, 1); PG8_STAGE(PG8_SB(0, 0), b2, voffB);
            PG8_BAR; PG8_WAIT_L(0); PG8_MMA(0, 1, At, B1); PG8_BAR;
            PG8_LDA(At, 0, 1); PG8_STAGE(PG8_SA(0, 0), a2, voffA);
            PG8_BAR; PG8_WAIT_L(0); PG8_MMA(1, 0, At, B0); PG8_BAR; PG8_SCHED;
            PG8_STAGE(PG8_SB(0, 1), b2 + hstep, voffB);
            PG8_WAIT_V(6); PG8_BAR; PG8_MMA(1, 1, At, B1); PG8_BAR;
            PG8_LDB(B0, 1, 0); PG8_SCHED; PG8_LDA(At, 1, 0); PG8_STAGE(PG8_SA(0, 1), a2 + hstep, voffA);
            PG8_WAIT_L(8); PG8_BAR; PG8_WAIT_L(0); PG8_MMA(0, 0, At, B0); PG8_BAR; PG8_SCHED;
            PG8_LDB(B1, 1, 1); PG8_STAGE(PG8_SB(1, 0), b3, voffB);
            PG8_BAR; PG8_WAIT_L(0); PG8_MMA(0, 1, At, B1); PG8_BAR;
            PG8_LDA(At, 1, 1); PG8_STAGE(PG8_SA(1, 0), a3, voffA);
            PG8_BAR; PG8_WAIT_L(0); PG8_MMA(1, 0, At, B0); PG8_BAR; PG8_SCHED;
            PG8_STAGE(PG8_SB(1, 1), b3 + hstep, voffB);
            PG8_WAIT_V(6); PG8_BAR; PG8_MMA(1, 1, At, B1); PG8_BAR;
            }
        }
        if constexpr (ALIGN_EPI) { if (wr == 0) PG8_BAR; }
        if constexpr (!Epi::AFTER_DRAIN) { E(acc, cur, wr, wc, fr, fq); S.done(cur); }
        if (!has_next) break;
#pragma unroll
        for (int a = 0; a < 2; ++a)
#pragma unroll
            for (int b = 0; b < 2; ++b)
#pragma unroll
                for (int m = 0; m < 4; ++m)
#pragma unroll
                    for (int n = 0; n < 2; ++n) acc[a][b][m][n] = (f32x4){0.f, 0.f, 0.f, 0.f};
        cur = nxt; cA = nA; cB = nB; ++ui;
        if constexpr (ALIGN_EPI) { if (wr == 1) PG8_BAR; }
    }
    PG8_WAIT_V(0);
    if constexpr (!ALIGN_EPI) { if (wr == 0) PG8_BAR; }
    PG8_BAR;
    if constexpr (Epi::AFTER_DRAIN) { E.fused(acc, cur, wr, wc, fr, fq, lds, wid, lane); S.done(cur); }
#undef PG8_SA
#undef PG8_SB
#undef PG8_STAGE
#undef PG8_LDA
#undef PG8_LDB
#undef PG8_MMA
#undef PG8_WAIT_V
#undef PG8_WAIT_L
#undef PG8_BAR
#undef PG8_SCHED
}
}
#define GAS __attribute__((address_space(1)))
#define LAS __attribute__((address_space(3)))
typedef unsigned short bf16;
typedef unsigned v4u __attribute__((ext_vector_type(4)));
typedef float f32x4 __attribute__((ext_vector_type(4)));
typedef short bf16x8 __attribute__((ext_vector_type(8)));
typedef GAS unsigned gu32;
typedef GAS unsigned long long gu64;
#define RLX_AGENT __ATOMIC_RELAXED, __HIP_MEMORY_SCOPE_AGENT
#define LDS_WAIT() asm volatile("s_waitcnt lgkmcnt(0)" ::: "memory")
#define VM_WAIT() asm volatile("s_waitcnt vmcnt(0)" ::: "memory")
__device__ __forceinline__ unsigned long long rt() { return __builtin_amdgcn_s_memrealtime(); }
__device__ __forceinline__ unsigned f2bf(float f) { unsigned u = __builtin_bit_cast(unsigned, f); return (u + 0x7fffu + ((u >> 16) & 1u)) >> 16; }
__device__ __forceinline__ unsigned pk2(float lo, float hi) { return f2bf(lo) | (f2bf(hi) << 16); }

#define XB_TMO      128
#define XB_XCNT(j)  (256  + 64 * (j))
#define XB_XSUB(j)  (1280 + 64 * (j))
#define XB_XGEN(j)  (2304 + 64 * (j))
#define XB_TOP      3328
#define XB_TOPGEN   3392
#define XCD_BAR_WORDS 3456
#define XB_SPIN_CAP (1u << 18)

__device__ __forceinline__ unsigned xb_ld(unsigned* p)              { return __hip_atomic_load(p, __ATOMIC_RELAXED, __HIP_MEMORY_SCOPE_AGENT); }
__device__ __forceinline__ unsigned xb_add(unsigned* p, unsigned v) { return __hip_atomic_fetch_add(p, v, __ATOMIC_RELAXED, __HIP_MEMORY_SCOPE_AGENT); }
__device__ __forceinline__ unsigned xb_xcc_id() { return (unsigned)__builtin_amdgcn_s_getreg((3 << 11) | 20) & 0xFu; }
#define XB_SPIN(cond, bar) do { unsigned _sp = 0; while (cond) { __builtin_amdgcn_s_sleep(1); \
    if ((++_sp & 255u) == 0u) { if (xb_ld(&(bar)[XB_TMO])) break; if (_sp > XB_SPIN_CAP) { atomicAdd(&(bar)[XB_TMO], 1u); break; } } } } while (0)

struct XcdBarrier {
    unsigned* bar; unsigned x;
    volatile LAS unsigned* st;
};

__device__ __forceinline__ XcdBarrier xcd_barrier_post(unsigned* bar, volatile LAS unsigned* st) {
    XcdBarrier b; b.bar = bar; b.x = xb_xcc_id(); b.st = st;
    if (threadIdx.x == 0) (void)xb_add(&bar[XB_XCNT(b.x)], 1u);
    return b;
}
__device__ __forceinline__ void xcd_barrier_complete(unsigned* bar, unsigned x, unsigned& nloc, unsigned& nx) {
    const unsigned G = gridDim.x * gridDim.y * gridDim.z;
    unsigned sum, cnt, mine, sp = 0u;
    for (;;) {
        sum = 0u; cnt = 0u; mine = 0u;
#pragma unroll
        for (unsigned j = 0; j < 16; ++j) { const unsigned c = xb_ld(&bar[XB_XCNT(j)]); sum += c; cnt += (c > 0u) ? 1u : 0u; mine = (j == x) ? c : mine; }
        if (sum == G) break;
        __builtin_amdgcn_s_sleep(1);
        if ((++sp & 255u) == 0u) { if (xb_ld(&bar[XB_TMO])) break; if (sp > XB_SPIN_CAP) { atomicAdd(&bar[XB_TMO], 1u); break; } }
    }
    nloc = mine > 0u ? mine : 1u; nx = cnt > 0u ? cnt : 1u;
}

__device__ __forceinline__ void xcd_barrier(const XcdBarrier& b) {
    asm volatile("s_waitcnt vmcnt(0)" ::: "memory");
    __syncthreads();
    if (threadIdx.x == 0) {
        unsigned* bar = b.bar;
        __builtin_amdgcn_s_waitcnt(0);
        unsigned nloc = b.st[0], nx = b.st[1];
        if (nloc == 0u) { xcd_barrier_complete(bar, b.x, nloc, nx); b.st[0] = nloc; b.st[1] = nx; }
        const unsigned old = xb_add(&bar[XB_XSUB(b.x)], 1u);
        const unsigned gen = old / nloc;
        if (old + 1u == (gen + 1u) * nloc) {
            __builtin_amdgcn_fence(__ATOMIC_RELEASE, "agent");
            asm volatile("s_waitcnt vmcnt(0)" ::: "memory");
            const unsigned og = xb_add(&bar[XB_TOP], 1u);
            const unsigned tg = og / nx;
            if (og + 1u == (tg + 1u) * nx) xb_add(&bar[XB_TOPGEN], 1u);
            else XB_SPIN(xb_ld(&bar[XB_TOPGEN]) == tg, bar);
            __builtin_amdgcn_fence(__ATOMIC_ACQUIRE, "agent");
            xb_add(&bar[XB_XGEN(b.x)], 1u);
            asm volatile("s_waitcnt vmcnt(0)" ::: "memory");
        } else {
            XB_SPIN(xb_ld(&bar[XB_XGEN(b.x)]) == gen, bar);
            __builtin_amdgcn_fence(__ATOMIC_ACQUIRE, "agent");
            asm volatile("s_waitcnt vmcnt(0)" ::: "memory");
        }
    }
    __syncthreads();
}

constexpr int NWAVES = 8, NTHR = 512;
constexpr int BATCH = 8, SEQ = 2048, D = 1024, M = BATCH * SEQ, DEPTH = 4;
constexpr int INC = 3120, NPROJ = 3328, DFF = 2816, NGU = 5632, MH = M / 2;
constexpr float EPS = 1e-6f;
constexpr int PC_AQK = 0, PC_AV = 512, PC_AO = 1024, PC_BQ = 1536, PC_BK = 1792, PC_BV = 2048, PC_BR = 2560, PC_GATES = 3072, PC_LR = 3088;
constexpr size_t MiB = 1u << 20;
constexpr size_t WS_CTL = 0, CTL_ZERO_BYTES = 1 * MiB;
constexpr size_t WS_WIN = 1 * MiB;
constexpr size_t WS_WOUT = WS_WIN + (size_t)NPROJ * D * 2;
constexpr size_t WS_WGU = WS_WOUT + (size_t)D * D * 2;
constexpr size_t WS_WDN = WS_WGU + (size_t)NGU * D * 2;
static_assert(WS_WDN + (size_t)D * DFF * 2 <= 27 * MiB, "weights");
constexpr size_t WS_P = 27 * MiB;
constexpr size_t WS_X = 131 * MiB;
constexpr size_t WS_H = 163 * MiB;
constexpr size_t WS_END = 251 * MiB;
constexpr int CW_BAR = 4096;
constexpr int RING_BYTES = 131072, LDSCTL_OFF = RING_BYTES, MISC_OFF = LDSCTL_OFF + 320, LDS_BYTES = 147456;

__device__ __forceinline__ float bf2f(bf16 h) { return __builtin_bit_cast(float, (unsigned)h << 16); }
__device__ __forceinline__ float wave_sum(float v) {
#pragma unroll
    for (int o = 1; o < 64; o <<= 1) v += __shfl_xor(v, o);
    return v;
}
__device__ __forceinline__ float logsigf(float x) { return fminf(x, 0.f) - log1pf(expf(-fabsf(x))); }
__device__ __forceinline__ float siluf(float x) { return x / (1.f + expf(-x)); }
__device__ __forceinline__ float gelu_tanh(float x) { const float u = 0.7978845608028654f * (x + 0.044715f * x * x * x); return 0.5f * x * (1.f + tanhf(u)); }

struct Args { const float* in[19]; float* out; unsigned char* ws; int ph_lo, ph_hi; };
static_assert(sizeof(Args) == 19 * 8 + 8 + 8 + 8, "no padding");

__device__ __forceinline__ void tr_item(const float* W, int ldw, int srccol, int k0, bf16* WT, int K, int dst0, LAS float* scr, int lane) {
#pragma unroll 8
    for (int i = 0; i < 32; ++i) { const int kk = 2 * i + (lane >> 5); scr[kk * 33 + (lane & 31)] = srccol >= 0 ? W[(size_t)(k0 + kk) * ldw + srccol] : 0.f; }
    LDS_WAIT(); asm volatile("" ::: "memory");
    const int c = lane & 7;
#pragma unroll
    for (int j = 0; j < 4; ++j) { const int n = (lane >> 3) + 8 * j; const LAS float* s = scr + (8 * c) * 33 + n;
        v4u o; o.x = pk2(s[0 * 33], s[1 * 33]); o.y = pk2(s[2 * 33], s[3 * 33]); o.z = pk2(s[4 * 33], s[5 * 33]); o.w = pk2(s[6 * 33], s[7 * 33]);
        *(v4u*)(WT + (size_t)(dst0 + n) * K + k0 + 8 * c) = o; }
    LDS_WAIT(); asm volatile("" ::: "memory");
}

constexpr int TAB_OFF = LDSCTL_OFF + 1024;
__device__ __forceinline__ const float* tab_ptr(LAS unsigned char* lds, int i) {
    volatile LAS unsigned* t = (volatile LAS unsigned*)(lds + TAB_OFF) + 2 * i;
    const unsigned a = __builtin_amdgcn_readfirstlane(t[0]), b = __builtin_amdgcn_readfirstlane(t[1]);
    return (const float*)(((unsigned long long)b << 32) | a);
}
#define TABP(i) tab_ptr(lds, (i))
__global__ void __launch_bounds__(NTHR, 2) fwd_kernel(Args args) {
    extern __shared__ __attribute__((aligned(16))) unsigned char lds_raw[];
    LAS unsigned char* lds = (LAS unsigned char*)lds_raw;
    volatile LAS unsigned* MISC = (volatile LAS unsigned*)(lds + MISC_OFF);
    {
        for (int u = threadIdx.x; u < (LDS_BYTES - LDSCTL_OFF) / 4; u += NTHR) ((LAS unsigned*)(lds + LDSCTL_OFF))[u] = 0u;
        __syncthreads();
        if (threadIdx.x < 21) { const unsigned long long p = threadIdx.x < 19 ? (unsigned long long)args.in[threadIdx.x] : threadIdx.x == 19 ? (unsigned long long)args.out : (unsigned long long)args.ws;
            ((LAS unsigned long long*)(lds + TAB_OFF))[threadIdx.x] = p; }
        __syncthreads();
    }
    const int G = gridDim.x, bx = blockIdx.x;
    XcdBarrier bar = xcd_barrier_post((unsigned*)((gu32*)TABP(20) + CW_BAR), MISC + 8);
    const int lo = args.ph_lo, hi = args.ph_hi;
    int ph = 0;
#define PHASE_BEGIN if (ph >= lo && ph < hi) { int tid = threadIdx.x; asm volatile("" : "+v"(tid)); const int lane = tid & 63, wave = __builtin_amdgcn_readfirstlane(tid >> 6); \
        const int gw = bx * NWAVES + wave, NGW = G * NWAVES; const long gt = (long)bx * NTHR + tid, NGT = (long)G * NTHR; unsigned char* const ws = (unsigned char*)TABP(20); \
        (void)lane; (void)wave; (void)gw; (void)NGW; (void)gt; (void)NGT; (void)ws;
#define PHASE_END   if (ph + 1 < hi) xcd_barrier(bar); } ++ph;

#define x_in   (TABP(0))
#define out    ((float*)TABP(19))
#define Win_t  ((bf16*)(ws + WS_WIN))
#define Wout_t ((bf16*)(ws + WS_WOUT))
#define Wgu_t  ((bf16*)(ws + WS_WGU))
#define Wdn_t  ((bf16*)(ws + WS_WDN))
#define PROJ   ((bf16*)(ws + WS_P))
#define GU     ((bf16*)(ws + WS_P))
#define FF     ((float*)(ws + WS_P))
#define XB     ((bf16*)(ws + WS_X))
#define QA     (XB)
#define KA     (XB + (size_t)M * 256)
#define LAF    (XB + (size_t)M * 512)
#define LAB    (XB + (size_t)M * 768)
#define HF     ((bf16*)(ws + WS_H))
#define HB     (HF + (size_t)M * D)
#define MIX    ((float*)(ws + WS_H))
#define ACT    ((bf16*)(ws + WS_H))
#define g_mix_pre  (TABP(1) + l * D)
#define g_mix_post (TABP(2) + l * D)
#define g_ffn_pre  (TABP(3) + l * D)
#define g_ffn_post (TABP(4) + l * D)
#define w_in    (TABP(5) + (size_t)l * D * INC)
#define gate_b  (TABP(6) + l * 16)
#define mconv_w (TABP(7) + l * 3 * 512)
#define mconv_b (TABP(8) + l * 512)
#define mnorm   (TABP(9) + l * 512)
#define gla_w2  (TABP(10) + l * 2 * 16 * 256)
#define gla_b   (TABP(11) + l * 512)
#define gnorm   (TABP(12) + l * 512)
#define w_out   (TABP(13) + (size_t)l * D * D)
#define w_gate  (TABP(14) + (size_t)l * D * DFF)
#define w_up    (TABP(15) + (size_t)l * D * DFF)
#define fconv_w (TABP(16) + l * 3 * DFF)
#define fconv_b (TABP(17) + l * DFF)
#define w_down  (TABP(18) + (size_t)l * DFF * D)
#define xcur    ((l == 0) ? x_in : (const float*)out)

    for (int l = 0; l < DEPTH; ++l) {
        PHASE_BEGIN
        {
            LAS float* scr = (LAS float*)(lds + wave * 16384);
            constexpr int I_IN = 16 * (NPROJ / 32), I_OUT = 16 * (D / 32), I_GU = 16 * (NGU / 32), I_DN = (DFF / 64) * (D / 32);
            for (int it = gw; it < I_IN + I_OUT + I_GU + I_DN; it += NGW) {
                int r = it;
                if (r < I_IN) { const int kb = r / (NPROJ / 32), db = r % (NPROJ / 32), d = 32 * db + (lane & 31);
                    const int src = d < 1536 ? d : d < 3072 ? d + 16 : d < 3088 ? d - 1536 : d < 3120 ? d : -1;
                    tr_item(w_in, INC, src, 64 * kb, Win_t, D, 32 * db, scr, lane); continue; }
                r -= I_IN;
                if (r < I_OUT) { const int kb = r / (D / 32), db = r % (D / 32); tr_item(w_out, D, 32 * db + (lane & 31), 64 * kb, Wout_t, D, 32 * db, scr, lane); continue; }
                r -= I_OUT;
                if (r < I_GU) { const int kb = r / (NGU / 32), db = r % (NGU / 32), d = 32 * db + (lane & 31), pn = d >> 8, rr = d & 255, bj = rr >> 7, j = rr & 127;
                    tr_item(bj ? w_up : w_gate, DFF, 128 * pn + j, 64 * kb, Wgu_t, D, 32 * db, scr, lane); continue; }
                r -= I_GU;
                { const int kb = r / (D / 32), db = r % (D / 32); tr_item(w_down, D, 32 * db + (lane & 31), 64 * kb, Wdn_t, DFF, 32 * db, scr, lane); }
            }
            for (int m = gw; m < M; m += NGW) {
                const float4* xr = (const float4*)(xcur + (size_t)m * D) + lane; const float4* gr = (const float4*)g_mix_pre + lane;
                float4 v[4]; float s = 0.f;
#pragma unroll
                for (int j = 0; j < 4; ++j) { v[j] = xr[64 * j]; s += (v[j].x * v[j].x + v[j].y * v[j].y) + (v[j].z * v[j].z + v[j].w * v[j].w); }
                const float r = 1.f / sqrtf(wave_sum(s) * (1.f / D) + EPS);
                unsigned long long* o8 = (unsigned long long*)(XB + (size_t)m * D) + lane;
#pragma unroll
                for (int j = 0; j < 4; ++j) { const float4 g = gr[64 * j];
                    o8[64 * j] = (unsigned long long)pk2(v[j].x * r * g.x, v[j].y * r * g.y) | ((unsigned long long)pk2(v[j].z * r * g.z, v[j].w * r * g.w) << 32); }
            }
        }
        PHASE_END

        PHASE_BEGIN
        {
            pg8::Gemm g{XB, Win_t, M, NPROJ, D}; pg8::StaticOrder S; S.init(M, NPROJ, G, bx);
            pg8::EpiBf16<0> E{PROJ, NPROJ, nullptr, 0, 0, 1.f};
            pg8::gemm_phase<pg8::EpiBf16<0>, pg8::StaticOrder, true, true>(lds, g, S, E);
        }
        PHASE_END

        PHASE_BEGIN
        for (long idx = gt; idx < (long)M * 256; idx += NGT) {
            const int t = (int)(idx >> 8), c = (int)(idx & 255), s = t & (SEQ - 1);
            const bf16* P = PROJ + (size_t)t * NPROJ;
            float vq, vk;
            { const float xm = s > 0 ? bf2f(P[-NPROJ + c]) : 0.f, x0 = bf2f(P[c]), xp = s < SEQ - 1 ? bf2f(P[NPROJ + c]) : 0.f;
              vq = xm * mconv_w[c] + x0 * mconv_w[512 + c] + xp * mconv_w[1024 + c] + mconv_b[c]; }
            { const int c2 = 256 + c; const float xm = s > 0 ? bf2f(P[-NPROJ + c2]) : 0.f, x0 = bf2f(P[c2]), xp = s < SEQ - 1 ? bf2f(P[NPROJ + c2]) : 0.f;
              vk = xm * mconv_w[c2] + x0 * mconv_w[512 + c2] + xp * mconv_w[1024 + c2] + mconv_b[c2]; }
            float a0 = gla_b[c], a1 = gla_b[256 + c];
#pragma unroll
            for (int r = 0; r < 16; ++r) { a0 += bf2f(P[PC_LR + r]) * gla_w2[r * 256 + c]; a1 += bf2f(P[PC_LR + 16 + r]) * gla_w2[(16 + r) * 256 + c]; }
            QA[idx] = (bf16)f2bf(siluf(vq)); KA[idx] = (bf16)f2bf(siluf(vk) * 0.125f);
            LAF[idx] = (bf16)f2bf(logsigf(a0) * (1.f / 16.f)); LAB[idx] = (bf16)f2bf(logsigf(a1) * (1.f / 16.f));
        }
        PHASE_END

        PHASE_BEGIN
        {
            LAS float* sq = (LAS float*)lds; LAS float* sk = sq + 4096; LAS float* sa = sk + 4096; LAS float* sv = sa + 4096; LAS float* snum = sv + 8192;
            LAS float* sg = snum + 8192; LAS float* sden = sg + 128; LAS float* sexm = sden + 64;
            for (int it = bx; it < 128; it += G) {
                const int dir = it & 1, grp = (it >> 1) & 1, bh = it >> 2, b = bh >> 2, h = bh & 3;
                float C[64]; float mst = 0.f;
#pragma unroll
                for (int d = 0; d < 64; ++d) C[d] = 0.f;
                bf16* Hout = dir ? HB : HF;
                const bf16* LA = dir ? LAB : LAF;
                for (int ci = 0; ci < 32; ++ci) {
                    const int c = dir ? 31 - ci : ci, t0 = b * SEQ + c * 64;
                    __syncthreads();
                    for (int e = tid; e < 4096; e += NTHR) { const int tt = e >> 6, d = e & 63; const size_t t = (size_t)(t0 + tt);
                        if (grp == 0) { sq[e] = bf2f(QA[t * 256 + h * 64 + d]); sk[e] = bf2f(KA[t * 256 + h * 64 + d]); }
                        else { sq[e] = bf2f(PROJ[t * NPROJ + PC_BQ + h * 64 + d]) * 0.125f; sk[e] = bf2f(PROJ[t * NPROJ + PC_BK + h * 64 + d]); sa[e] = expf(bf2f(LA[t * 256 + h * 64 + d])); } }
                    for (int e = tid; e < 8192; e += NTHR) { const int tt = e >> 7, ee = e & 127; const size_t t = (size_t)(t0 + tt);
                        sv[e] = bf2f(PROJ[t * NPROJ + (grp == 0 ? PC_AV : PC_BV) + h * 128 + ee]); }
                    if (tid < 64 && grp == 0) { const size_t t = (size_t)(t0 + tid);
                        sg[2 * tid] = bf2f(PROJ[t * NPROJ + PC_GATES + dir * 8 + h]) + gate_b[dir * 8 + h];
                        sg[2 * tid + 1] = logsigf(bf2f(PROJ[t * NPROJ + PC_GATES + dir * 8 + 4 + h]) + gate_b[dir * 8 + 4 + h]); }
                    __syncthreads();
                    if (tid < 128 || (tid == 128 && grp == 0)) {
                        for (int st = 0; st < 64; ++st) {
                            const int tt = dir ? 63 - st : st;
                            const float v = tid < 128 ? sv[tt * 128 + tid] : 1.f;
                            float num = 0.f;
                            if (grp == 0) {
                                const float ii = sg[2 * tt], lf = sg[2 * tt + 1];
                                const float mn = fmaxf(lf + mst, ii), dec = expf(lf + mst - mn), wi = expf(ii - mn) * v;
#pragma unroll
                                for (int d = 0; d < 64; ++d) { C[d] = dec * C[d] + sk[tt * 64 + d] * wi; num += sq[tt * 64 + d] * C[d]; }
                                mst = mn;
                                if (tid == 128) { sden[tt] = num; sexm[tt] = expf(-mn); }
                            } else {
#pragma unroll
                                for (int d = 0; d < 64; ++d) { C[d] = sa[tt * 64 + d] * C[d] + sk[tt * 64 + d] * v; num += sq[tt * 64 + d] * C[d]; }
                            }
                            if (tid < 128) snum[tt * 128 + tid] = num;
                        }
                    }
                    __syncthreads();
                    for (int e = tid; e < 8192; e += NTHR) { const int tt = e >> 7, ee = e & 127;
                        float o = snum[e]; if (grp == 0) o = o / fmaxf(fabsf(sden[tt]), sexm[tt]);
                        Hout[(size_t)(t0 + tt) * D + grp * 512 + h * 128 + ee] = (bf16)f2bf(o); }
                }
            }
        }
        PHASE_END

        PHASE_BEGIN
        for (int idx = gw; idx < M * 8; idx += NGW) {
            const int t = idx >> 3, hs = idx & 7, e = 2 * lane;
            const size_t off = (size_t)t * D + hs * 128 + e;
            const unsigned a = *(const unsigned*)(HF + off), bq = *(const unsigned*)(HB + off);
            const float h0 = bf2f((bf16)(a & 0xffff)) + bf2f((bf16)(bq & 0xffff)), h1 = bf2f((bf16)(a >> 16)) + bf2f((bf16)(bq >> 16));
            const float r = 1.f / sqrtf(wave_sum(h0 * h0 + h1 * h1) * (1.f / 128.f) + EPS);
            const bf16* P = PROJ + (size_t)t * NPROJ + (hs < 4 ? PC_AO + hs * 128 : PC_BR + (hs - 4) * 128) + e;
            const float p0 = bf2f(P[0]), p1 = bf2f(P[1]);
            const float* nw = (hs < 4 ? mnorm + hs * 128 : gnorm + (hs - 4) * 128) + e;
            const float g0 = hs < 4 ? 1.f / (1.f + expf(-p0)) : siluf(p0), g1 = hs < 4 ? 1.f / (1.f + expf(-p1)) : siluf(p1);
            *(unsigned*)(XB + off) = pk2(g0 * h0 * r * nw[0], g1 * h1 * r * nw[1]);
        }
        PHASE_END

        PHASE_BEGIN
        {
            pg8::Gemm g{XB, Wout_t, M, D, D}; pg8::StaticOrder S; S.init(M, D, G, bx);
            pg8::EpiF32 E{MIX, D, nullptr};
            pg8::gemm_phase<pg8::EpiF32, pg8::StaticOrder, true, true>(lds, g, S, E);
        }
        PHASE_END

        PHASE_BEGIN
        for (int m = gw; m < M; m += NGW) {
            const float4* mr = (const float4*)(MIX + (size_t)m * D) + lane; const float4* xr = (const float4*)(xcur + (size_t)m * D) + lane;
            const float4* g1 = (const float4*)g_mix_post + lane; const float4* g2 = (const float4*)g_ffn_pre + lane;
            float4 v[4], xv[4]; float s = 0.f;
#pragma unroll
            for (int j = 0; j < 4; ++j) { v[j] = mr[64 * j]; xv[j] = xr[64 * j]; s += (v[j].x * v[j].x + v[j].y * v[j].y) + (v[j].z * v[j].z + v[j].w * v[j].w); }
            const float r = 1.f / sqrtf(wave_sum(s) * (1.f / D) + EPS); float s2 = 0.f;
#pragma unroll
            for (int j = 0; j < 4; ++j) { const float4 g = g1[64 * j];
                xv[j].x += v[j].x * r * g.x; xv[j].y += v[j].y * r * g.y; xv[j].z += v[j].z * r * g.z; xv[j].w += v[j].w * r * g.w;
                s2 += (xv[j].x * xv[j].x + xv[j].y * xv[j].y) + (xv[j].z * xv[j].z + xv[j].w * xv[j].w); }
            const float r2 = 1.f / sqrtf(wave_sum(s2) * (1.f / D) + EPS);
            float4* orow = (float4*)(out + (size_t)m * D) + lane; unsigned long long* o8 = (unsigned long long*)(XB + (size_t)m * D) + lane;
#pragma unroll
            for (int j = 0; j < 4; ++j) { const float4 g = g2[64 * j]; orow[64 * j] = xv[j];
                o8[64 * j] = (unsigned long long)pk2(xv[j].x * r2 * g.x, xv[j].y * r2 * g.y) | ((unsigned long long)pk2(xv[j].z * r2 * g.z, xv[j].w * r2 * g.w) << 32); }
        }
        PHASE_END

        for (int hf = 0; hf < 2; ++hf) {
            PHASE_BEGIN
            {
                pg8::Gemm g{XB + (size_t)hf * MH * D, Wgu_t, MH, NGU, D}; pg8::StaticOrder S; S.init(MH, NGU, G, bx);
                pg8::EpiBf16<0> E{GU, NGU, nullptr, 0, 0, 1.f};
                pg8::gemm_phase<pg8::EpiBf16<0>, pg8::StaticOrder, true, true>(lds, g, S, E);
            }
            PHASE_END
            PHASE_BEGIN
            for (long idx = gt; idx < (long)MH * DFF; idx += NGT) {
                const int tl = (int)(idx / DFF), c = (int)(idx % DFF), t = hf * MH + tl, s = t & (SEQ - 1);
                const int cg = (c >> 7) * 256 + (c & 127);
                const bf16* P = GU + (size_t)tl * NGU + cg;
                const float gm = s > 0 ? bf2f(P[-NGU]) : 0.f, g0 = bf2f(P[0]), gp = s < SEQ - 1 ? bf2f(P[NGU]) : 0.f, u = bf2f(P[128]);
                const float gc = gm * fconv_w[c] + g0 * fconv_w[DFF + c] + gp * fconv_w[2 * DFF + c] + fconv_b[c];
                ACT[(size_t)t * DFF + c] = (bf16)f2bf(gelu_tanh(gc) * u);
            }
            PHASE_END
        }

        PHASE_BEGIN
        {
            pg8::Gemm g{ACT, Wdn_t, M, D, DFF}; pg8::StaticOrder S; S.init(M, D, G, bx);
            pg8::EpiF32 E{FF, D, nullptr};
            pg8::gemm_phase<pg8::EpiF32, pg8::StaticOrder, true, true>(lds, g, S, E);
        }
        PHASE_END

        PHASE_BEGIN
        for (int m = gw; m < M; m += NGW) {
            const float4* fr = (const float4*)(FF + (size_t)m * D) + lane; float4* xr = (float4*)(out + (size_t)m * D) + lane;
            const float4* g1 = (const float4*)g_ffn_post + lane;
            float4 v[4]; float s = 0.f;
#pragma unroll
            for (int j = 0; j < 4; ++j) { v[j] = fr[64 * j]; s += (v[j].x * v[j].x + v[j].y * v[j].y) + (v[j].z * v[j].z + v[j].w * v[j].w); }
            const float r = 1.f / sqrtf(wave_sum(s) * (1.f / D) + EPS);
#pragma unroll
            for (int j = 0; j < 4; ++j) { const float4 g = g1[64 * j]; float4 xv = xr[64 * j];
                xv.x += v[j].x * r * g.x; xv.y += v[j].y * r * g.y; xv.z += v[j].z * r * g.z; xv.w += v[j].w * r * g.w; xr[64 * j] = xv; }
        }
        PHASE_END
    }
#undef PHASE_BEGIN
#undef PHASE_END
}
#undef x_in
#undef out
#undef Win_t
#undef Wout_t
#undef Wgu_t
#undef Wdn_t
#undef PROJ
#undef GU
#undef FF
#undef XB
#undef QA
#undef KA
#undef LAF
#undef LAB
#undef HF
#undef HB
#undef MIX
#undef ACT
#undef g_mix_pre
#undef g_mix_post
#undef g_ffn_pre
#undef g_ffn_post
#undef w_in
#undef gate_b
#undef mconv_w
#undef mconv_b
#undef mnorm
#undef gla_w2
#undef gla_b
#undef gnorm
#undef w_out
#undef w_gate
#undef w_up
#undef fconv_w
#undef fconv_b
#undef w_down
#undef xcur

#ifndef MK_PER_PHASE
#define MK_PER_PHASE 0
#endif
constexpr int N_PHASES = DEPTH * 13;

extern "C" void kernel_launch(void* const* d_in, const int* in_sizes, int n_in, void* d_out, int out_size, void* d_ws, size_t ws_size, hipStream_t stream) {
    static int grid = 0;
    if (grid == 0) {
        if (n_in != 19 || in_sizes[0] != M * D || out_size != M * D || ws_size < WS_END) { fprintf(stderr, "kernel_launch: unexpected shapes (n_in %d, in0 %d, out %d, ws %zu)\n", n_in, n_in > 0 ? in_sizes[0] : -1, out_size, ws_size); grid = -1; return; }
        int dev = 0, cus = 0, per_cu = 0;
        if (hipGetDevice(&dev) != hipSuccess || hipDeviceGetAttribute(&cus, hipDeviceAttributeMultiprocessorCount, dev) != hipSuccess) { grid = -1; return; }
        if (hipFuncSetAttribute((const void*)fwd_kernel, hipFuncAttributeMaxDynamicSharedMemorySize, LDS_BYTES) != hipSuccess) { fprintf(stderr, "kernel_launch: hipFuncSetAttribute failed\n"); grid = -1; return; }
        if (hipOccupancyMaxActiveBlocksPerMultiprocessor(&per_cu, (const void*)fwd_kernel, NTHR, LDS_BYTES) != hipSuccess || per_cu < 1) { fprintf(stderr, "kernel_launch: occupancy query says %d\n", per_cu); per_cu = 1; }
        (void)hipGetLastError();
        grid = cus;
    }
    if (grid < 0) return;
    (void)hipMemsetAsync((char*)d_ws + WS_CTL, 0, CTL_ZERO_BYTES, stream);
    Args a{};
    for (int i = 0; i < 19; ++i) a.in[i] = (const float*)d_in[i];
    a.out = (float*)d_out; a.ws = (unsigned char*)d_ws;
#if MK_PER_PHASE
    for (int p = 0; p < N_PHASES; ++p) { a.ph_lo = p; a.ph_hi = p + 1; hipLaunchKernelGGL(fwd_kernel, dim3(grid), dim3(NTHR), LDS_BYTES, stream, a); }
#else
    a.ph_lo = 0; a.ph_hi = N_PHASES;
    hipLaunchKernelGGL(fwd_kernel, dim3(grid), dim3(NTHR), LDS_BYTES, stream, a);
#endif
}
```

```cpp
#include <hip/hip_runtime.h>
#include <cstdio>
#include <cstdint>
namespace pg8 {
#define PG8_LAS __attribute__((address_space(3)))
typedef unsigned short bf16_t;
typedef short bf16x8 __attribute__((ext_vector_type(8)));
typedef float f32x4 __attribute__((ext_vector_type(4)));
typedef unsigned u32x4 __attribute__((ext_vector_type(4)));
constexpr int BM = 256, BK = 64, HALF = 128, HTB = HALF * BK * 2  , STAGE_BYTES = 8 * HTB, NXCD = 8, WGM = 8;

__host__ __device__ __forceinline__ int lds_byte(int r, int c) { const int st = (r >> 4) * 2 + (c >> 5), rr = r & 15, cc = c & 31, ob = rr * 64 + cc * 2; return st * 1024 + (ob ^ (((ob >> 9) & 1) << 5)); }
__host__ __device__ __forceinline__ void stage_rc(int b, int& R, int& C) { const int st = b / 1024, sb = b % 1024, swz = sb ^ (((sb >> 9) & 1) << 5); R = (st >> 1) * 16 + swz / 64; C = (st & 1) * 32 + (swz % 64) / 2; }
__host__ __device__ __forceinline__ int perm32(int rho) { const int n = rho >> 4, i = rho & 15; return 8 * (i >> 2) + 4 * n + (i & 3); }

struct Unit { int pm, pn; };
struct Gemm { const bf16_t* A; const bf16_t* Bt; int M, N, K; };

struct StaticOrder {
    int nM, nN, nwg, G, c;
    __host__ __device__ void init(int M, int N, int G_, int c_) { nM = M / BM; nN = N / BM; nwg = nM * nN; G = G_; c = c_; }
    __host__ __device__ bool next(int i, Unit& u) const {
        const long L = (long)i * G + c; if (L >= nwg) return false;
        int wgid = (int)L; { const int q = nwg / NXCD, r = nwg % NXCD, xcd = wgid % NXCD, off = wgid / NXCD; wgid = (xcd < r ? xcd * (q + 1) : r * (q + 1) + (xcd - r) * q) + off; }
        const int nig = WGM * nN, gid = wgid / nig, fm = gid * WGM, gsz = (nM - fm) < WGM ? (nM - fm) : WGM;
        u.pm = fm + ((wgid % nig) % gsz); u.pn = (wgid % nig) / gsz; return true;
    }
    __device__ __forceinline__ void a_ready(const Unit&) const {}
    __device__ __forceinline__ void done(const Unit&) const {}
};

__device__ __forceinline__ unsigned cvt_pk_bf16(float lo, float hi) { unsigned r; asm volatile("v_cvt_pk_bf16_f32 %0, %1, %2" : "=v"(r) : "v"(lo), "v"(hi)); return r; }
typedef float f32x2 __attribute__((ext_vector_type(2)));
__device__ __forceinline__ f32x2 gelu_pk(f32x2 v) {
    const f32x2 av = __builtin_elementwise_abs(v), d = av * 0.2316418882f + 1.0f;
    f32x2 t; t.x = __builtin_amdgcn_rcpf(d.x); t.y = __builtin_amdgcn_rcpf(d.y);
    f32x2 q = t * 0.5307027145f + (-0.7265760135f); q = q * t + 0.7107068705f; q = q * t + (-0.142248368f); q = q * t + 0.127414796f; q = q * t;
    const f32x2 s = (v * v) * (-0.72134752044f);
    f32x2 e; e.x = __builtin_amdgcn_exp2f(s.x); e.y = __builtin_amdgcn_exp2f(s.y);
    const f32x2 m = v * (q * e), r = v - m;
    f32x2 o; o.x = v.x < 0.f ? m.x : r.x; o.y = v.y < 0.f ? m.y : r.y; return o;
}

template <int ACT  > struct EpiBf16 {
    static constexpr bool PERM = true, AFTER_DRAIN = false; static_assert(ACT == 0 || ACT == 1, "EpiBf16: ACT is 0 (none) or 1 (gelu_pk)");
    bf16_t* O; int ldc; const float* bias; int split_cols; size_t split_stride; float scale0;
    __device__ __forceinline__ void operator()(const f32x4 (&acc)[2][2][4][2], const Unit& u, int wr, int wc, int fr, int fq) const {
        const int row0 = u.pm * BM + wr * 64 + fr; int colt = u.pn * BM; bf16_t* base = O;
        float sc = 1.f; if (split_cols) { const int t = colt / split_cols; base += (size_t)t * split_stride; colt -= t * split_cols; if (t == 0) sc = scale0; }
        const int col0 = colt + wc * 32 + 8 * fq, bcol0 = u.pn * BM + wc * 32 + 8 * fq;
        f32x4 bv[2][2];
#pragma unroll
        for (int bj = 0; bj < 2; ++bj)
#pragma unroll
            for (int n = 0; n < 2; ++n) bv[bj][n] = bias ? *(const f32x4*)(bias + bcol0 + bj * HALF + 4 * n) : (f32x4){0.f, 0.f, 0.f, 0.f};
#pragma unroll
        for (int ai = 0; ai < 2; ++ai)
#pragma unroll
            for (int m = 0; m < 4; ++m) { bf16_t* rowp = base + (size_t)(row0 + ai * HALF + m * 16) * ldc + col0;
#pragma unroll
                for (int bj = 0; bj < 2; ++bj) { f32x4 v0 = acc[ai][bj][m][0] + bv[bj][0], v1 = acc[ai][bj][m][1] + bv[bj][1];
                    if (ACT == 1) { f32x2 a = gelu_pk((f32x2){v0[0], v0[1]}), b = gelu_pk((f32x2){v0[2], v0[3]}), c = gelu_pk((f32x2){v1[0], v1[1]}), d = gelu_pk((f32x2){v1[2], v1[3]});
                        v0 = (f32x4){a.x, a.y, b.x, b.y}; v1 = (f32x4){c.x, c.y, d.x, d.y}; }
                    v0 = v0 * sc; v1 = v1 * sc; u32x4 w; w.x = cvt_pk_bf16(v0[0], v0[1]); w.y = cvt_pk_bf16(v0[2], v0[3]); w.z = cvt_pk_bf16(v1[0], v1[1]); w.w = cvt_pk_bf16(v1[2], v1[3]);
                    *(u32x4*)(rowp + bj * HALF) = w; } }
    }
};
struct EpiF32 {
    static constexpr bool PERM = false, AFTER_DRAIN = false;
    float* C; int ldc; const float* bias;
    __device__ __forceinline__ void operator()(const f32x4 (&acc)[2][2][4][2], const Unit& u, int wr, int wc, int fr, int fq) const {
        const int row0 = u.pm * BM + wr * 64 + fr, col0 = u.pn * BM + wc * 32 + 4 * fq;
        f32x4 bv[2][2];
#pragma unroll
        for (int bj = 0; bj < 2; ++bj)
#pragma unroll
            for (int n = 0; n < 2; ++n) bv[bj][n] = bias ? *(const f32x4*)(bias + col0 + bj * HALF + n * 16) : (f32x4){0.f, 0.f, 0.f, 0.f};
#pragma unroll
        for (int ai = 0; ai < 2; ++ai)
#pragma unroll
            for (int m = 0; m < 4; ++m) { float* rowp = C + (size_t)(row0 + ai * HALF + m * 16) * ldc + col0;
#pragma unroll
                for (int bj = 0; bj < 2; ++bj)
#pragma unroll
                    for (int n = 0; n < 2; ++n) *(f32x4*)(rowp + bj * HALF + n * 16) = acc[ai][bj][m][n] + bv[bj][n]; }
    }
};
template <class Epi, class Sched, bool ALIGN_EPI = false, bool SP2 = false>
__device__ __forceinline__ void gemm_phase(PG8_LAS unsigned char* lds, const Gemm g, const Sched& S, const Epi& E) {
    int tid_ = threadIdx.x; asm volatile("" : "+v"(tid_));
    const int tid = tid_, wid = __builtin_amdgcn_readfirstlane(tid >> 6), lane = tid & 63, wr = wid >> 2, wc = wid & 3, fr = lane & 15, fq = lane >> 4;
    const int K = g.K, nt = K / BK;
    unsigned voffA[2], voffB[2];
#pragma unroll
    for (int i = 0; i < 2; ++i) { int R, C; stage_rc(tid * 16 + i * 8192, R, C); const int Rb = Epi::PERM ? ((R & ~31) + perm32(R & 31)) : R;
        voffA[i] = (unsigned)(R * K + C) * 2u; voffB[i] = (unsigned)(Rb * K + C) * 2u; }
    const size_t kstep = (size_t)(BK * 2);
    const size_t hstep = (size_t)HALF * K * 2;
    const size_t tstep = 2 * hstep;
    const unsigned ldsw = (unsigned)wid * 1024u;
    const int aoff = lds_byte(wr * 64 + fr, fq * 8), boff = lds_byte(wc * 32 + fr, fq * 8);
#define PG8_SA(b, h) (((b) * 2 + (h)) * HTB)
#define PG8_SB(b, h) ((4 + (b) * 2 + (h)) * HTB)
#define PG8_STAGE(bufoff, gbase, voff) do { _Pragma("unroll") for (int _i = 0; _i < 2; ++_i) \
        __builtin_amdgcn_global_load_lds((const unsigned*)((const char*)(gbase) + (voff)[_i]), (PG8_LAS unsigned*)(lds + (bufoff) + ldsw + _i * 8192), 16, 0, 0); } while (0)
#define PG8_LDA(dst, b, h) do { _Pragma("unroll") for (int m = 0; m < 4; ++m) _Pragma("unroll") for (int k = 0; k < 2; ++k) dst[m][k] = *(const PG8_LAS bf16x8*)(lds + PG8_SA(b, h) + aoff + m * 2048 + k * 1024); } while (0)
#define PG8_LDB(dst, b, h) do { _Pragma("unroll") for (int n = 0; n < 2; ++n) _Pragma("unroll") for (int k = 0; k < 2; ++k) dst[n][k] = *(const PG8_LAS bf16x8*)(lds + PG8_SB(b, h) + boff + n * 2048 + k * 1024); } while (0)
#define PG8_MMA(ai, bj, At, Bt) do { __builtin_amdgcn_s_setprio(1); _Pragma("unroll") for (int m = 0; m < 4; ++m) _Pragma("unroll") for (int n = 0; n < 2; ++n) _Pragma("unroll") for (int k = 0; k < 2; ++k) \
        acc[ai][bj][m][n] = __builtin_amdgcn_mfma_f32_16x16x32_bf16(Bt[n][k], At[m][k], acc[ai][bj][m][n], 0, 0, 0); __builtin_amdgcn_s_setprio(0); } while (0)
#define PG8_WAIT_V(n) asm volatile("s_waitcnt vmcnt(" #n ")" ::: "memory")
#define PG8_WAIT_L(n) asm volatile("s_waitcnt lgkmcnt(" #n ")" ::: "memory")
#define PG8_BAR __builtin_amdgcn_s_barrier()
#define PG8_SCHED __builtin_amdgcn_sched_barrier(0)
    Unit cur, nxt; int ui = 0;
    if (!S.next(0, cur)) return;
    f32x4 acc[2][2][4][2];
#pragma unroll
    for (int a = 0; a < 2; ++a)
#pragma unroll
        for (int b = 0; b < 2; ++b)
#pragma unroll
            for (int m = 0; m < 4; ++m)
#pragma unroll
                for (int n = 0; n < 2; ++n) acc[a][b][m][n] = (f32x4){0.f, 0.f, 0.f, 0.f};
    bf16x8 At[4][2], B0[2][2], B1[2][2];
    const char* cA = (const char*)g.A + (size_t)cur.pm * tstep; const char* cB = (const char*)g.Bt + (size_t)cur.pn * tstep;
    S.a_ready(cur);
    if constexpr (SP2) {
        PG8_STAGE(PG8_SB(0, 0), cB, voffB); PG8_STAGE(PG8_SB(0, 1), cB + hstep, voffB); PG8_STAGE(PG8_SA(0, 0), cA, voffA); PG8_STAGE(PG8_SA(0, 1), cA + hstep, voffA);
        if (wr == 1) PG8_BAR;
        PG8_WAIT_V(2); PG8_BAR;
        PG8_STAGE(PG8_SB(1, 0), cB + kstep, voffB); PG8_STAGE(PG8_SA(1, 0), cA + kstep, voffA); PG8_STAGE(PG8_SB(1, 1), cB + hstep + kstep, voffB);
        PG8_WAIT_V(6); PG8_BAR;
    } else {
        PG8_STAGE(PG8_SB(0, 0), cB, voffB); PG8_STAGE(PG8_SA(0, 0), cA, voffA); PG8_STAGE(PG8_SB(0, 1), cB + hstep, voffB); PG8_STAGE(PG8_SA(0, 1), cA + hstep, voffA);
        if (wr == 1) PG8_BAR;
        PG8_WAIT_V(4); PG8_BAR;
        PG8_STAGE(PG8_SB(1, 0), cB + kstep, voffB); PG8_STAGE(PG8_SA(1, 0), cA + kstep, voffA); PG8_STAGE(PG8_SB(1, 1), cB + hstep + kstep, voffB);
        PG8_WAIT_V(6); PG8_BAR;
    }
    for (;;) {
        const bool has_next = S.next(ui + 1, nxt);
        const char* nA = has_next ? (const char*)g.A + (size_t)nxt.pm * tstep : cA; const char* nB = has_next ? (const char*)g.Bt + (size_t)nxt.pn * tstep : cB;
        for (int t = 0; t < nt; t += 2) {
            const bool last = (t == nt - 2);
            const char* a1 = cA + (size_t)(t + 1) * kstep;
            const char* a2 = last ? nA : cA + (size_t)(t + 2) * kstep; const char* b2 = last ? nB : cB + (size_t)(t + 2) * kstep;
            const char* a3 = a2 + kstep; const char* b3 = b2 + kstep;
            if (last && has_next) S.a_ready(nxt);
            if constexpr (SP2) {
            PG8_LDB(B0, 0, 0); PG8_LDB(B1, 0, 1); PG8_SCHED; PG8_LDA(At, 0, 0); PG8_STAGE(PG8_SA(1, 1), a1 + hstep, voffA);
            PG8_WAIT_V(8); PG8_WAIT_L(0); PG8_BAR; PG8_MMA(0, 0, At, B0); PG8_MMA(0, 1, At, B1); PG8_BAR; PG8_SCHED;
            PG8_LDA(At, 0, 1); PG8_STAGE(PG8_SB(0, 0), b2, voffB); PG8_STAGE(PG8_SB(0, 1), b2 + hstep, voffB); PG8_STAGE(PG8_SA(0, 0), a2, voffA);
            PG8_WAIT_V(8); PG8_WAIT_L(0); PG8_BAR; PG8_MMA(1, 0, At, B0); PG8_MMA(1, 1, At, B1); PG8_BAR; PG8_SCHED;
            PG8_LDB(B0, 1, 0); PG8_LDB(B1, 1, 1); PG8_SCHED; PG8_LDA(At, 1, 0); PG8_STAGE(PG8_SA(0, 1), a2 + hstep, voffA);
            PG8_WAIT_V(8); PG8_WAIT_L(0); PG8_BAR; PG8_MMA(0, 0, At, B0); PG8_MMA(0, 1, At, B1); PG8_BAR; PG8_SCHED;
            PG8_LDA(At, 1, 1); PG8_STAGE(PG8_SB(1, 0), b3, voffB); PG8_STAGE(PG8_SB(1, 1), b3 + hstep, voffB); PG8_STAGE(PG8_SA(1, 0), a3, voffA);
            PG8_WAIT_V(8); PG8_WAIT_L(0); PG8_BAR; PG8_MMA(1, 0, At, B0); PG8_MMA(1, 1, At, B1); PG8_BAR; PG8_SCHED;
            } else {
            PG8_LDB(B0, 0, 0); PG8_SCHED; PG8_LDA(At, 0, 0); PG8_STAGE(PG8_SA(1, 1), a1 + hstep, voffA);
            PG8_WAIT_L(8); PG8_BAR; PG8_WAIT_L(0); PG8_MMA(0, 0, At, B0); PG8_BAR; PG8_SCHED;
            PG8_LDB(B1, 0, 1); PG8_STAGE(PG8_SB(0, 0), b2, voffB);
            PG8_BAR; PG8_WAIT_L(0); PG8_MMA(0, 1, At, B1); PG8_BAR;
            PG8_LDA(At, 0, 1); PG8_STAGE(PG8_SA(0, 0), a2, voffA);
            PG8_BAR; PG8_WAIT_L(0); PG8_MMA(1, 0, At, B0); PG8_BAR; PG8_SCHED;
            PG8_STAGE(PG8_SB(0, 1), b2 + hstep, voffB);
            PG8_WAIT_V(6); PG8_BAR; PG8_MMA(1, 1, At, B1); PG8_BAR;
            PG8_LDB(B0, 1, 0); PG8_SCHED; PG8_LDA(At, 1, 0); PG8_STAGE(PG8_SA(0, 1), a2 + hstep, voffA);
            PG8_WAIT_L(8); PG8_BAR; PG8_WAIT_L(0); PG8_MMA(0, 0, At, B0); PG8_BAR; PG8_SCHED;
            PG8_LDB(B1, 1, 1); PG8_STAGE(PG8_SB(1, 0), b3, voffB);
            PG8_BAR; PG8_WAIT_L(0); PG8_MMA(0, 1, At, B1); PG8_BAR;
            PG8_LDA(At, 1, 1); PG8_STAGE(PG8_SA(1, 0), a3, voffA);
            PG8_BAR; PG8_WAIT_L(0); PG8_MMA(1, 0, At, B0); PG8_BAR; PG8_SCHED;
            PG8_STAGE(PG8_SB(1, 1), b3 + hstep, voffB);
            PG8_WAIT_V(6); PG8_BAR; PG8_MMA(1, 1, At, B1); PG8_BAR;
            }
        }
        if constexpr (ALIGN_EPI) { if (wr == 0) PG8_BAR; }
        if constexpr (!Epi::AFTER_DRAIN) { E(acc, cur, wr, wc, fr, fq); S.done(cur); }
        if (!has_next) break;
#pragma unroll
        for (int a = 0; a < 2; ++a)
#pragma unroll
            for (int b = 0; b < 2; ++b)
#pragma unroll
                for (int m = 0; m < 4; ++m)
#pragma unroll
                    for (int n = 0; n < 2; ++n) acc[a][b][m][n] = (f32x4){0.f, 0.f, 0.f, 0.f};
        cur = nxt; cA = nA; cB = nB; ++ui;
        if constexpr (ALIGN_EPI) { if (wr == 1) PG8_BAR; }
    }
    PG8_WAIT_V(0);
    if constexpr (!ALIGN_EPI) { if (wr == 0) PG8_BAR; }
    PG8_BAR;
    if constexpr (Epi::AFTER_DRAIN) { E.fused(acc, cur, wr, wc, fr, fq, lds, wid, lane); S.done(cur); }
#undef PG8_SA
#undef PG8_SB
#undef PG8_STAGE
#undef PG8_LDA
#undef PG8_LDB
#undef PG8_MMA
#undef PG8_WAIT_V
#undef PG8_WAIT_L
#undef PG8_BAR
#undef PG8_SCHED
}
}
#define GAS __attribute__((address_space(1)))
#define LAS __attribute__((address_space(3)))
typedef unsigned short bf16;
typedef unsigned v4u __attribute__((ext_vector_type(4)));
typedef float f32x4 __attribute__((ext_vector_type(4)));
typedef short bf16x8 __attribute__((ext_vector_type(8)));
typedef GAS unsigned gu32;
typedef GAS unsigned long long gu64;
#define RLX_AGENT __ATOMIC_RELAXED, __HIP_MEMORY_SCOPE_AGENT
#define LDS_WAIT() asm volatile("s_waitcnt lgkmcnt(0)" ::: "memory")
#define VM_WAIT() asm volatile("s_waitcnt vmcnt(0)" ::: "memory")
__device__ __forceinline__ unsigned long long rt() { return __builtin_amdgcn_s_memrealtime(); }
__device__ __forceinline__ unsigned f2bf(float f) { unsigned u = __builtin_bit_cast(unsigned, f); return (u + 0x7fffu + ((u >> 16) & 1u)) >> 16; }
__device__ __forceinline__ unsigned pk2(float lo, float hi) { return f2bf(lo) | (f2bf(hi) << 16); }

#define XB_TMO      128
#define XB_XCNT(j)  (256  + 64 * (j))
#define XB_XSUB(j)  (1280 + 64 * (j))
#define XB_XGEN(j)  (2304 + 64 * (j))
#define XB_TOP      3328
#define XB_TOPGEN   3392
#define XCD_BAR_WORDS 3456
#define XB_SPIN_CAP (1u << 18)

__device__ __forceinline__ unsigned xb_ld(unsigned* p)              { return __hip_atomic_load(p, __ATOMIC_RELAXED, __HIP_MEMORY_SCOPE_AGENT); }
__device__ __forceinline__ unsigned xb_add(unsigned* p, unsigned v) { return __hip_atomic_fetch_add(p, v, __ATOMIC_RELAXED, __HIP_MEMORY_SCOPE_AGENT); }
__device__ __forceinline__ unsigned xb_xcc_id() { return (unsigned)__builtin_amdgcn_s_getreg((3 << 11) | 20) & 0xFu; }
#define XB_SPIN(cond, bar) do { unsigned _sp = 0; while (cond) { __builtin_amdgcn_s_sleep(1); \
    if ((++_sp & 255u) == 0u) { if (xb_ld(&(bar)[XB_TMO])) break; if (_sp > XB_SPIN_CAP) { atomicAdd(&(bar)[XB_TMO], 1u); break; } } } } while (0)

struct XcdBarrier {
    unsigned* bar; unsigned x;
    volatile LAS unsigned* st;
};

__device__ __forceinline__ XcdBarrier xcd_barrier_post(unsigned* bar, volatile LAS unsigned* st) {
    XcdBarrier b; b.bar = bar; b.x = xb_xcc_id(); b.st = st;
    if (threadIdx.x == 0) (void)xb_add(&bar[XB_XCNT(b.x)], 1u);
    return b;
}
__device__ __forceinline__ void xcd_barrier_complete(unsigned* bar, unsigned x, unsigned& nloc, unsigned& nx) {
    const unsigned G = gridDim.x * gridDim.y * gridDim.z;
    unsigned sum, cnt, mine, sp = 0u;
    for (;;) {
        sum = 0u; cnt = 0u; mine = 0u;
#pragma unroll
        for (unsigned j = 0; j < 16; ++j) { const unsigned c = xb_ld(&bar[XB_XCNT(j)]); sum += c; cnt += (c > 0u) ? 1u : 0u; mine = (j == x) ? c : mine; }
        if (sum == G) break;
        __builtin_amdgcn_s_sleep(1);
        if ((++sp & 255u) == 0u) { if (xb_ld(&bar[XB_TMO])) break; if (sp > XB_SPIN_CAP) { atomicAdd(&bar[XB_TMO], 1u); break; } }
    }
    nloc = mine > 0u ? mine : 1u; nx = cnt > 0u ? cnt : 1u;
}

__device__ __forceinline__ void xcd_barrier(const XcdBarrier& b) {
    asm volatile("s_waitcnt vmcnt(0)" ::: "memory");
    __syncthreads();
    if (threadIdx.x == 0) {
        unsigned* bar = b.bar;
        __builtin_amdgcn_s_waitcnt(0);
        unsigned nloc = b.st[0], nx = b.st[1];
        if (nloc == 0u) { xcd_barrier_complete(bar, b.x, nloc, nx); b.st[0] = nloc; b.st[1] = nx; }
        const unsigned old = xb_add(&bar[XB_XSUB(b.x)], 1u);
        const unsigned gen = old / nloc;
        if (old + 1u == (gen + 1u) * nloc) {
            __builtin_amdgcn_fence(__ATOMIC_RELEASE, "agent");
            asm volatile("s_waitcnt vmcnt(0)" ::: "memory");
            const unsigned og = xb_add(&bar[XB_TOP], 1u);
            const unsigned tg = og / nx;
            if (og + 1u == (tg + 1u) * nx) xb_add(&bar[XB_TOPGEN], 1u);
            else XB_SPIN(xb_ld(&bar[XB_TOPGEN]) == tg, bar);
            __builtin_amdgcn_fence(__ATOMIC_ACQUIRE, "agent");
            xb_add(&bar[XB_XGEN(b.x)], 1u);
            asm volatile("s_waitcnt vmcnt(0)" ::: "memory");
        } else {
            XB_SPIN(xb_ld(&bar[XB_XGEN(b.x)]) == gen, bar);
            __builtin_amdgcn_fence(__ATOMIC_ACQUIRE, "agent");
            asm volatile("s_waitcnt vmcnt(0)" ::: "memory");
        }
    }
    __syncthreads();
}

constexpr int NWAVES = 8, NTHR = 512;
constexpr int BATCH = 8, SEQ = 2048, D = 1024, M = BATCH * SEQ, DEPTH = 4, NCH = SEQ / 64;
constexpr int INC = 3120, NPROJ = 3328, DFF = 2816, NGU = 5632, MH = M / 2;
constexpr float EPS = 1e-6f;
constexpr int PC_AQK = 0, PC_AV = 512, PC_AO = 1024, PC_BQ = 1536, PC_BK = 1792, PC_BV = 2048, PC_BR = 2560, PC_GATES = 3072, PC_LR = 3088;
constexpr size_t MiB = 1u << 20;
constexpr size_t WS_CTL = 0, CTL_ZERO_BYTES = 1 * MiB;
constexpr size_t WS_WOUT = 1 * MiB;
constexpr size_t WS_WIN = 3 * MiB;
constexpr size_t WS_ONES = 9 * MiB + 512 * 1024;
constexpr size_t WS_P = 10 * MiB;
constexpr size_t WS_HT = WS_P, WS_DEN = WS_P + 64 * MiB, WS_HN2 = WS_P, WS_GU = WS_P + 32 * MiB, WS_FF = WS_P + 32 * MiB;
constexpr size_t WS_Q = 114 * MiB;
constexpr size_t WS_QFM = WS_Q, WS_KFM = WS_Q + 8 * MiB, WS_KTM = WS_Q + 16 * MiB, WS_VTM = WS_Q + 24 * MiB;
constexpr size_t WS_QFG = WS_Q + 40 * MiB, WS_KFG = WS_Q + 56 * MiB, WS_KTG = WS_Q + 72 * MiB, WS_VTG = WS_Q + 88 * MiB;
constexpr size_t WS_Y = WS_Q, WS_MIX = WS_Q + 32 * MiB, WS_ACT = WS_Q + 16 * MiB;
constexpr size_t WS_G = 218 * MiB;
constexpr size_t WS_GATES = WS_G, WS_WGU = WS_G, WS_WDN = WS_G + 11 * MiB, WS_HN = WS_G;
constexpr size_t WS_AUXM = 250 * MiB, WS_AUXG = 254 * MiB;
constexpr size_t WS_END = 256 * MiB;
constexpr int CW_BAR = 4096;
constexpr int RING_BYTES = 131072, LDS_BYTES = 147456, LDSCTL_OFF = 143360, MISC_OFF = LDSCTL_OFF + 320, TAB_OFF = LDSCTL_OFF + 1024;
constexpr int SLOT_BUF = 30720, SLOT_BYTES = 2 * SLOT_BUF, SCR_OFF = 2 * SLOT_BYTES;
constexpr int SB_QF = 0, SB_KF = 8192, SB_KT = 16384, SB_VT = 24576, SB_AUX = 28672;

typedef float f32x16 __attribute__((ext_vector_type(16)));
typedef unsigned u32x2 __attribute__((ext_vector_type(2)));
#define MFMA32(a, b, c) __builtin_amdgcn_mfma_f32_32x32x16_bf16((a), (b), (c), 0, 0, 0)

__device__ __forceinline__ float bf2f(bf16 h) { return __builtin_bit_cast(float, (unsigned)h << 16); }
__device__ __forceinline__ float bflo(unsigned w) { return __builtin_bit_cast(float, w << 16); }
__device__ __forceinline__ float bfhi(unsigned w) { return __builtin_bit_cast(float, w & 0xffff0000u); }
__device__ __forceinline__ float wave_sum(float v) {
#pragma unroll
    for (int o = 1; o < 64; o <<= 1) v += __shfl_xor(v, o);
    return v;
}
__device__ __forceinline__ float logsigf(float x) { return fminf(x, 0.f) - log1pf(expf(-fabsf(x))); }
__device__ __forceinline__ float siluf(float x) { return x / (1.f + expf(-x)); }
__device__ __forceinline__ float sigmf(float x) { return 1.f / (1.f + expf(-x)); }
__device__ __forceinline__ float gelu_tanh(float x) { const float u = 0.7978845608028654f * (x + 0.044715f * x * x * x); return 0.5f * x * (1.f + tanhf(u)); }
__device__ __forceinline__ int kperm(int ks, int hh, int j) { return 16 * ks + 8 * (j >> 2) + 4 * hh + (j & 3); }
__device__ __forceinline__ bf16x8 pack8(float a0, float a1, float a2, float a3, float a4, float a5, float a6, float a7) {
    v4u p;
    asm volatile("v_cvt_pk_bf16_f32 %0, %4, %5\n\tv_cvt_pk_bf16_f32 %1, %6, %7\n\tv_cvt_pk_bf16_f32 %2, %8, %9\n\tv_cvt_pk_bf16_f32 %3, %10, %11\n\ts_nop 1"
                 : "=&v"(p.x), "=&v"(p.y), "=&v"(p.z), "=&v"(p.w) : "v"(a0), "v"(a1), "v"(a2), "v"(a3), "v"(a4), "v"(a5), "v"(a6), "v"(a7));
    return __builtin_bit_cast(bf16x8, p);
}
#define PACK_STEP(x, s) pack8((x)[8 * (s)], (x)[8 * (s) + 1], (x)[8 * (s) + 2], (x)[8 * (s) + 3], (x)[8 * (s) + 4], (x)[8 * (s) + 5], (x)[8 * (s) + 6], (x)[8 * (s) + 7])

struct Args { const float* in[19]; float* out; unsigned char* ws; int ph_lo, ph_hi; };
static_assert(sizeof(Args) == 19 * 8 + 8 + 8 + 8, "no padding");

__device__ __forceinline__ void tr_item(const float* W, int ldw, int srccol, int k0, bf16* WT, int K, int dst0, LAS float* scr, int lane) {
#pragma unroll 8
    for (int i = 0; i < 32; ++i) { const int kk = 2 * i + (lane >> 5); scr[kk * 33 + (lane & 31)] = srccol >= 0 ? W[(size_t)(k0 + kk) * ldw + srccol] : 0.f; }
    LDS_WAIT(); asm volatile("" ::: "memory");
    const int c = lane & 7;
#pragma unroll
    for (int j = 0; j < 4; ++j) { const int n = (lane >> 3) + 8 * j; const LAS float* s = scr + (8 * c) * 33 + n;
        v4u o; o.x = pk2(s[0 * 33], s[1 * 33]); o.y = pk2(s[2 * 33], s[3 * 33]); o.z = pk2(s[4 * 33], s[5 * 33]); o.w = pk2(s[6 * 33], s[7 * 33]);
        *(v4u*)(WT + (size_t)(dst0 + n) * K + k0 + 8 * c) = o; }
    LDS_WAIT(); asm volatile("" ::: "memory");
}

__device__ __forceinline__ const float* tab_ptr(LAS unsigned char* lds, int i) {
    volatile LAS unsigned* t = (volatile LAS unsigned*)(lds + TAB_OFF) + 2 * i;
    const unsigned a = __builtin_amdgcn_readfirstlane(t[0]), b = __builtin_amdgcn_readfirstlane(t[1]);
    return (const float*)(((unsigned long long)b << 32) | a);
}
#define TABP(i) tab_ptr(lds, (i))

__device__ __forceinline__ void prep_unit(LAS unsigned char* lds, unsigned char* ws, int u, int tid, int l) {
    const int b = u >> 5, c = u & 31, t0 = b * SEQ + c * 64, lane = tid & 63, wave = tid >> 6;
    const bf16* PROJ = (const bf16*)(ws + WS_P);
    LAS float* sb = (LAS float*)lds;
    LAS float* slr = (LAS float*)(lds + 131072);
    LAS float* sg = (LAS float*)(lds + 131072 + 8192);
    const float* gate_b = TABP(6) + l * 16;
    const float* mconv_w = TABP(7) + l * 3 * 512; const float* mconv_b = TABP(8) + l * 512;
    const float* gla_w2 = TABP(10) + l * 2 * 16 * 256; const float* gla_b = TABP(11) + l * 512;
    __syncthreads();
    for (int e = tid; e < 64 * 32; e += NTHR) slr[e] = bf2f(PROJ[(size_t)(t0 + (e >> 5)) * NPROJ + PC_LR + (e & 31)]);
    for (int e = tid; e < 64 * 16; e += NTHR) sg[e] = bf2f(PROJ[(size_t)(t0 + (e >> 4)) * NPROJ + PC_GATES + (e & 15)]) + gate_b[e & 15];
    __syncthreads();
    {
        const int dir = tid >> 8, cc = tid & 255;
        float w[16];
#pragma unroll
        for (int r = 0; r < 16; ++r) w[r] = gla_w2[(dir * 16 + r) * 256 + cc];
        const float gb = gla_b[dir * 256 + cc]; float bsum = 0.f;
        for (int st = 0; st < 64; ++st) { const int tt = dir ? 63 - st : st; float a = gb;
#pragma unroll
            for (int r = 0; r < 16; ++r) a += slr[tt * 32 + dir * 16 + r] * w[r];
            bsum += logsigf(a) * (1.f / 16.f); sb[(dir * 64 + tt) * 256 + cc] = bsum; }
        float* AUXG = (float*)(ws + WS_AUXG);
        AUXG[(size_t)((((b * 4 + (cc >> 6)) * 2 + dir) * NCH) + c) * 256 + (cc & 63)] = expf(bsum);
    }
    {
        const int h = wave & 3, dir = wave >> 2, tt = dir ? 63 - lane : lane;
        const float ii = sg[tt * 16 + dir * 8 + h], lf = logsigf(sg[tt * 16 + dir * 8 + 4 + h]);
        float bs = lf;
#pragma unroll
        for (int o = 1; o < 64; o <<= 1) { const float t = __shfl_up(bs, o); if (lane >= o) bs += t; }
        const float uu = ii - bs; float pm = uu;
#pragma unroll
        for (int o = 1; o < 64; o <<= 1) { const float t = __shfl_up(pm, o); if (lane >= o) pm = fmaxf(pm, t); }
        const float pml = __shfl(pm, 63), bl = __shfl(bs, 63);
        float* A = (float*)(ws + WS_AUXM) + (size_t)((((b * 4 + h) * 2 + dir) * NCH) + c) * 512;
        A[tt] = uu; A[64 + tt] = pm; A[128 + tt] = bs; A[192 + tt] = pml; A[256 + tt] = bl;
    }
    __syncthreads();
    const int rec = 0;  (void)rec;
    for (int idx = tid; idx < 4096; idx += NTHR) {
        const int which = idx >> 11, h = (idx >> 9) & 3, frag = idx & 511, tt = frag >> 8, ks = (frag >> 6) & 3, L = frag & 63, hh = L >> 5, r = L & 31;
        const int tl = 32 * tt + r, s = c * 64 + tl; const size_t t = (size_t)(t0 + tl);
        const int cb = which * 256 + h * 64 + 16 * ks + 4 * hh;
        float v[8];
#pragma unroll
        for (int g = 0; g < 2; ++g) { const int col = cb + 8 * g; const bf16* P = PROJ + t * NPROJ + col;
            const u32x2 x0 = *(const u32x2*)P;
            u32x2 xm = {0u, 0u}, xp = {0u, 0u};
            if (s > 0) xm = *(const u32x2*)(P - NPROJ);
            if (s < SEQ - 1) xp = *(const u32x2*)(P + NPROJ);
            const f32x4 w0 = *(const f32x4*)(mconv_w + col), w1 = *(const f32x4*)(mconv_w + 512 + col), w2 = *(const f32x4*)(mconv_w + 1024 + col), bb = *(const f32x4*)(mconv_b + col);
            v[4 * g + 0] = bflo(xm.x) * w0[0] + bflo(x0.x) * w1[0] + bflo(xp.x) * w2[0] + bb[0];
            v[4 * g + 1] = bfhi(xm.x) * w0[1] + bfhi(x0.x) * w1[1] + bfhi(xp.x) * w2[1] + bb[1];
            v[4 * g + 2] = bflo(xm.y) * w0[2] + bflo(x0.y) * w1[2] + bflo(xp.y) * w2[2] + bb[2];
            v[4 * g + 3] = bfhi(xm.y) * w0[3] + bfhi(x0.y) * w1[3] + bfhi(xp.y) * w2[3] + bb[3]; }
        const float sc = which ? 0.125f : 1.f;
        v4u o; o.x = pk2(siluf(v[0]) * sc, siluf(v[1]) * sc); o.y = pk2(siluf(v[2]) * sc, siluf(v[3]) * sc); o.z = pk2(siluf(v[4]) * sc, siluf(v[5]) * sc); o.w = pk2(siluf(v[6]) * sc, siluf(v[7]) * sc);
        *(v4u*)(ws + (which ? WS_KFM : WS_QFM) + (size_t)(((b * 4 + h) * NCH + c) * 8192) + frag * 16) = o;
    }
    for (int idx = tid; idx < 2048; idx += NTHR) {
        const int h = idx >> 9, frag = idx & 511, dt = frag >> 8, ks = (frag >> 6) & 3, L = frag & 63, hh = L >> 5, r = L & 31;
        const int col = 256 + h * 64 + 32 * dt + r;
        const float w0 = mconv_w[col], w1 = mconv_w[512 + col], w2 = mconv_w[1024 + col], bb = mconv_b[col];
        float v[8];
#pragma unroll
        for (int j = 0; j < 8; ++j) { const int tl = kperm(ks, hh, j), s = c * 64 + tl; const bf16* P = PROJ + (size_t)(t0 + tl) * NPROJ + col;
            const float xm = s > 0 ? bf2f(P[-NPROJ]) : 0.f, x0 = bf2f(P[0]), xp = s < SEQ - 1 ? bf2f(P[NPROJ]) : 0.f;
            v[j] = siluf(xm * w0 + x0 * w1 + xp * w2 + bb) * 0.125f; }
        v4u o; o.x = pk2(v[0], v[1]); o.y = pk2(v[2], v[3]); o.z = pk2(v[4], v[5]); o.w = pk2(v[6], v[7]);
        *(v4u*)(ws + WS_KTM + (size_t)(((b * 4 + h) * NCH + c) * 8192) + frag * 16) = o;
    }
    for (int idx = tid; idx < 8192; idx += NTHR) {
        const int grp = idx >> 12, h = (idx >> 10) & 3, et = (idx >> 8) & 3, frag = idx & 255, ks = frag >> 6, L = frag & 63, hh = L >> 5, r = L & 31;
        const int col = (grp ? PC_BV : PC_AV) + h * 128 + 32 * et + r;
        unsigned v[8];
#pragma unroll
        for (int j = 0; j < 8; ++j) v[j] = PROJ[(size_t)(t0 + kperm(ks, hh, j)) * NPROJ + col];
        v4u o; o.x = v[0] | (v[1] << 16); o.y = v[2] | (v[3] << 16); o.z = v[4] | (v[5] << 16); o.w = v[6] | (v[7] << 16);
        *(v4u*)(ws + (grp ? WS_VTG : WS_VTM) + (size_t)((((b * 4 + h) * NCH + c) * 4 + et) * 4096) + frag * 16) = o;
    }
    for (int idx = tid; idx < 8192; idx += NTHR) {
        const int dir = idx >> 12, which = (idx >> 11) & 1, h = (idx >> 9) & 3, frag = idx & 511, tt = frag >> 8, ks = (frag >> 6) & 3, L = frag & 63, hh = L >> 5, r = L & 31;
        const int tl = 32 * tt + r, cl = h * 64 + 16 * ks + 4 * hh;
        const bf16* P = PROJ + (size_t)(t0 + tl) * NPROJ + (which ? PC_BK : PC_BQ) + cl;
        const LAS float* B = sb + (dir * 64 + tl) * 256 + cl;
        float v[8];
#pragma unroll
        for (int g = 0; g < 2; ++g) { const u32x2 x = *(const u32x2*)(P + 8 * g); const f32x4 bb = *(const LAS f32x4*)(B + 8 * g);
            const float xs[4] = {bflo(x.x), bfhi(x.x), bflo(x.y), bfhi(x.y)};
#pragma unroll
            for (int q = 0; q < 4; ++q) v[4 * g + q] = which ? xs[q] * expf(-bb[q]) : xs[q] * 0.125f * expf(bb[q]); }
        v4u o; o.x = pk2(v[0], v[1]); o.y = pk2(v[2], v[3]); o.z = pk2(v[4], v[5]); o.w = pk2(v[6], v[7]);
        *(v4u*)(ws + (which ? WS_KFG : WS_QFG) + (size_t)(((dir * 32 + b * 4 + h) * NCH + c)) * 8192 + frag * 16) = o;
    }
    for (int idx = tid; idx < 4096; idx += NTHR) {
        const int dir = idx >> 11, h = (idx >> 9) & 3, frag = idx & 511, dt = frag >> 8, ks = (frag >> 6) & 3, L = frag & 63, hh = L >> 5, r = L & 31;
        const int cl = h * 64 + 32 * dt + r;
        float v[8];
#pragma unroll
        for (int j = 0; j < 8; ++j) { const int tl = kperm(ks, hh, j); v[j] = bf2f(PROJ[(size_t)(t0 + tl) * NPROJ + PC_BK + cl]) * expf(-sb[(dir * 64 + tl) * 256 + cl]); }
        v4u o; o.x = pk2(v[0], v[1]); o.y = pk2(v[2], v[3]); o.z = pk2(v[4], v[5]); o.w = pk2(v[6], v[7]);
        *(v4u*)(ws + WS_KTG + (size_t)(((dir * 32 + b * 4 + h) * NCH + c)) * 8192 + frag * 16) = o;
    }
    for (int idx = tid; idx < 64 * 128; idx += NTHR) {
        const int tl = idx >> 7, c8 = (idx & 127) * 8;
        const v4u x = *(const v4u*)(PROJ + (size_t)(t0 + tl) * NPROJ + (c8 < 512 ? PC_AO + c8 : PC_BR + (c8 - 512)));
        const unsigned xw[4] = {x.x, x.y, x.z, x.w}; unsigned ow[4];
#pragma unroll
        for (int q = 0; q < 4; ++q) { const float a = bflo(xw[q]), bq = bfhi(xw[q]); ow[q] = c8 < 512 ? pk2(sigmf(a), sigmf(bq)) : pk2(siluf(a), siluf(bq)); }
        v4u o = {ow[0], ow[1], ow[2], ow[3]};
        *(v4u*)((bf16*)(ws + WS_GATES) + (size_t)(t0 + tl) * D + c8) = o;
    }
}

struct ScanItem { const unsigned char *qf, *kf, *kt, *vt, *aux; bf16* ht; float* den; int gla, bwd, wden; };
#define SCAN_DMA(dst_off, src, pieces) do { _Pragma("unroll") for (int _p = 0; _p < (pieces); ++_p) \
    __builtin_amdgcn_global_load_lds((const unsigned*)((src) + _p * 1024 + lane * 16), (LAS unsigned*)(sl + (dst_off) + _p * 1024), 16, 0, 0); } while (0)
__device__ __forceinline__ void scan_issue(LAS unsigned char* sl, int buf, const ScanItem& it, int c, int lane) {
    const int o = buf * SLOT_BUF;
    SCAN_DMA(o + SB_QF, it.qf + (size_t)c * 8192, 8);
    SCAN_DMA(o + SB_KF, it.kf + (size_t)c * 8192, 8);
    SCAN_DMA(o + SB_KT, it.kt + (size_t)c * 8192, 8);
    SCAN_DMA(o + SB_VT, it.vt + (size_t)c * 16384, 4);
    SCAN_DMA(o + SB_AUX, it.aux + (size_t)c * (it.gla ? 1024 : 2048), 2);
}
template <bool GLA, bool WDEN> __device__ __forceinline__ void scan_wave(LAS unsigned char* sl, LAS float* scr, const ScanItem& it, int lane) {
    const int hh = lane >> 5, r = lane & 31;
    f32x16 C0, C1, N0, N1;
#pragma unroll
    for (int i = 0; i < 16; ++i) { C0[i] = 0.f; C1[i] = 0.f; N0[i] = 0.f; N1[i] = 0.f; }
    float mst = 0.f;
    const bf16x8 ones = {0x3F80, 0x3F80, 0x3F80, 0x3F80, 0x3F80, 0x3F80, 0x3F80, 0x3F80};
    scan_issue(sl, 0, it, it.bwd ? NCH - 1 : 0, lane);
    for (int ci = 0; ci < NCH; ++ci) {
        const int c = it.bwd ? NCH - 1 - ci : ci, buf = ci & 1;
        asm volatile("s_waitcnt vmcnt(0)" ::: "memory");
        if (ci + 1 < NCH) scan_issue(sl, buf ^ 1, it, it.bwd ? c - 1 : c + 1, lane);
        LAS unsigned char* B = sl + buf * SLOT_BUF;
        const LAS float* aux = (const LAS float*)(B + SB_AUX);
        float dec = 1.f;
        if constexpr (!GLA) {
            const float uu = aux[lane], pm = aux[64 + lane], bb = aux[128 + lane], pml = aux[192 + lane], bl = aux[256 + lane];
            const float Mt = fmaxf(mst, pm), Ml = fmaxf(mst, pml);
            scr[lane] = expf(Ml - Mt); scr[64 + lane] = expf(uu - Ml); scr[128 + lane] = expf(-(bb + Mt));
            dec = expf(mst - Ml); mst = bl + Ml;
#pragma unroll
            for (int i = 0; i < 16; ++i) { C0[i] *= dec; C1[i] *= dec; N0[i] *= dec; N1[i] *= dec; }
        }
        const bf16x8 cp0 = PACK_STEP(C0, 0), cp1 = PACK_STEP(C0, 1), cp2 = PACK_STEP(C1, 0), cp3 = PACK_STEP(C1, 1);
        bf16x8 np0 = ones, np1 = ones, np2 = ones, np3 = ones;
        if constexpr (WDEN) { np0 = PACK_STEP(N0, 0); np1 = PACK_STEP(N0, 1); np2 = PACK_STEP(N1, 0); np3 = PACK_STEP(N1, 1); }
#pragma unroll
        for (int tt = 0; tt < 2; ++tt) {
            bf16x8 qf[4];
#pragma unroll
            for (int ks = 0; ks < 4; ++ks) qf[ks] = *(const LAS bf16x8*)(B + SB_QF + (tt * 4 + ks) * 1024 + lane * 16);
            float sqc = 1.f; if constexpr (!GLA) sqc = scr[32 * tt + r];
            bf16x8 sp[4];
#pragma unroll
            for (int st = 0; st < 2; ++st) {
                f32x16 X;
#pragma unroll
                for (int i = 0; i < 16; ++i) X[i] = 0.f;
#pragma unroll
                for (int ks = 0; ks < 4; ++ks) X = MFMA32(*(const LAS bf16x8*)(B + SB_KF + (st * 4 + ks) * 1024 + lane * 16), qf[ks], X);
#pragma unroll
                for (int g = 0; g < 4; ++g) {
                    f32x4 skr = {1.f, 1.f, 1.f, 1.f};
                    if constexpr (!GLA) skr = *(const LAS f32x4*)(scr + 64 + 32 * st + 8 * g + 4 * hh);
#pragma unroll
                    for (int q = 0; q < 4; ++q) { const int s = 32 * st + 8 * g + 4 * hh + q, t = 32 * tt + r;
                        const bool keep = it.bwd ? (s >= t) : (s <= t);
                        X[4 * g + q] = keep ? (GLA ? X[4 * g + q] : X[4 * g + q] * (skr[q] * sqc)) : 0.f; }
                }
                sp[2 * st] = PACK_STEP(X, 0); sp[2 * st + 1] = PACK_STEP(X, 1);
            }
            f32x4 sqr[4];
#pragma unroll
            for (int g = 0; g < 4; ++g) { sqr[g] = (f32x4){1.f, 1.f, 1.f, 1.f}; if constexpr (!GLA) sqr[g] = *(const LAS f32x4*)(scr + 32 * tt + 8 * g + 4 * hh); }
            f32x16 acc;
#pragma unroll
            for (int i = 0; i < 16; ++i) acc[i] = 0.f;
            acc = MFMA32(qf[0], cp0, acc); acc = MFMA32(qf[1], cp1, acc); acc = MFMA32(qf[2], cp2, acc); acc = MFMA32(qf[3], cp3, acc);
            if constexpr (!GLA) {
#pragma unroll
                for (int i = 0; i < 16; ++i) acc[i] *= sqr[i >> 2][i & 3];
            }
#pragma unroll
            for (int ks = 0; ks < 4; ++ks) acc = MFMA32(sp[ks], *(const LAS bf16x8*)(B + SB_VT + ks * 1024 + lane * 16), acc);
            {
                bf16* o = it.ht + (size_t)r * SEQ + c * 64 + 32 * tt + 4 * hh;
#pragma unroll
                for (int g = 0; g < 4; ++g) { u32x2 w; w.x = pk2(acc[4 * g], acc[4 * g + 1]); w.y = pk2(acc[4 * g + 2], acc[4 * g + 3]); *(u32x2*)(o + 8 * g) = w; }
            }
            if constexpr (WDEN) {
                f32x16 dac;
#pragma unroll
                for (int i = 0; i < 16; ++i) dac[i] = 0.f;
                dac = MFMA32(qf[0], np0, dac); dac = MFMA32(qf[1], np1, dac); dac = MFMA32(qf[2], np2, dac); dac = MFMA32(qf[3], np3, dac);
#pragma unroll
                for (int i = 0; i < 16; ++i) dac[i] *= sqr[i >> 2][i & 3];
#pragma unroll
                for (int ks = 0; ks < 4; ++ks) dac = MFMA32(sp[ks], ones, dac);
                if (r == 0) {
#pragma unroll
                    for (int g = 0; g < 4; ++g) { const f32x4 em = *(const LAS f32x4*)(scr + 128 + 32 * tt + 8 * g + 4 * hh); f32x4 dn;
#pragma unroll
                        for (int q = 0; q < 4; ++q) dn[q] = fmaxf(fabsf(dac[4 * g + q]), em[q]);
                        *(f32x4*)(it.den + c * 64 + 32 * tt + 8 * g + 4 * hh) = dn; }
                }
            }
        }
        bf16x8 vp[4], skf[4];
#pragma unroll
        for (int ks = 0; ks < 4; ++ks) {
            const v4u vv = *(const LAS v4u*)(B + SB_VT + ks * 1024 + lane * 16);
            if constexpr (GLA) { vp[ks] = __builtin_bit_cast(bf16x8, vv); skf[ks] = ones; }
            else { const f32x4 s0 = *(const LAS f32x4*)(scr + 64 + 16 * ks + 4 * hh), s1 = *(const LAS f32x4*)(scr + 64 + 16 * ks + 8 + 4 * hh);
                vp[ks] = pack8(bflo(vv.x) * s0[0], bfhi(vv.x) * s0[1], bflo(vv.y) * s0[2], bfhi(vv.y) * s0[3], bflo(vv.z) * s1[0], bfhi(vv.z) * s1[1], bflo(vv.w) * s1[2], bfhi(vv.w) * s1[3]);
                skf[ks] = pack8(s0[0], s0[1], s0[2], s0[3], s1[0], s1[1], s1[2], s1[3]); }
        }
#pragma unroll
        for (int ks = 0; ks < 4; ++ks) { const bf16x8 k0 = *(const LAS bf16x8*)(B + SB_KT + ks * 1024 + lane * 16), k1 = *(const LAS bf16x8*)(B + SB_KT + (4 + ks) * 1024 + lane * 16);
            C0 = MFMA32(k0, vp[ks], C0); C1 = MFMA32(k1, vp[ks], C1);
            if constexpr (WDEN) { N0 = MFMA32(k0, skf[ks], N0); N1 = MFMA32(k1, skf[ks], N1); } }
        if constexpr (GLA) {
#pragma unroll
            for (int g = 0; g < 4; ++g) { const f32x4 e0 = *(const LAS f32x4*)(aux + 8 * g + 4 * hh), e1 = *(const LAS f32x4*)(aux + 32 + 8 * g + 4 * hh);
#pragma unroll
                for (int q = 0; q < 4; ++q) { C0[4 * g + q] *= e0[q]; C1[4 * g + q] *= e1[q]; } }
        }
        asm volatile("s_waitcnt lgkmcnt(0)" ::: "memory");
    }
    asm volatile("s_waitcnt vmcnt(0)" ::: "memory");
}

__global__ void __launch_bounds__(NTHR, 2) fwd_kernel(Args args) {
    extern __shared__ __attribute__((aligned(16))) unsigned char lds_raw[];
    LAS unsigned char* lds = (LAS unsigned char*)lds_raw;
    volatile LAS unsigned* MISC = (volatile LAS unsigned*)(lds + MISC_OFF);
    {
        for (int u = threadIdx.x; u < (LDS_BYTES - LDSCTL_OFF) / 4; u += NTHR) ((LAS unsigned*)(lds + LDSCTL_OFF))[u] = 0u;
        __syncthreads();
        if (threadIdx.x < 21) { const unsigned long long p = threadIdx.x < 19 ? (unsigned long long)args.in[threadIdx.x] : threadIdx.x == 19 ? (unsigned long long)args.out : (unsigned long long)args.ws;
            ((LAS unsigned long long*)(lds + TAB_OFF))[threadIdx.x] = p; }
        __syncthreads();
    }
    const int G = gridDim.x, bx = blockIdx.x;
    XcdBarrier bar = xcd_barrier_post((unsigned*)((gu32*)TABP(20) + CW_BAR), MISC + 8);
    const int lo = args.ph_lo, hi = args.ph_hi;
#define x_in   (TABP(0))
#define out    ((float*)TABP(19))
#define Win_t  ((bf16*)(ws + WS_WIN))
#define Wout_t ((bf16*)(ws + WS_WOUT))
#define Wgu_t  ((bf16*)(ws + WS_WGU))
#define Wdn_t  ((bf16*)(ws + WS_WDN))
#define PROJ   ((bf16*)(ws + WS_P))
#define GU     ((bf16*)(ws + WS_GU))
#define FF     ((float*)(ws + WS_FF))
#define HN     ((bf16*)(ws + WS_HN))
#define HN2    ((bf16*)(ws + WS_HN2))
#define YB     ((bf16*)(ws + WS_Y))
#define MIX    ((float*)(ws + WS_MIX))
#define ACT    ((bf16*)(ws + WS_ACT))
#define g_mix_pre  (TABP(1) + l * D)
#define g_mix_post (TABP(2) + l * D)
#define g_ffn_pre  (TABP(3) + l * D)
#define g_ffn_post (TABP(4) + l * D)
#define w_in    (TABP(5) + (size_t)l * D * INC)
#define mnorm   (TABP(9) + l * 512)
#define gnorm   (TABP(12) + l * 512)
#define w_out   (TABP(13) + (size_t)l * D * D)
#define w_gate  (TABP(14) + (size_t)l * D * DFF)
#define w_up    (TABP(15) + (size_t)l * D * DFF)
#define fconv_w (TABP(16) + l * 3 * DFF)
#define fconv_b (TABP(17) + l * DFF)
#define w_down  (TABP(18) + (size_t)l * DFF * D)
#define xcur    ((l == 0) ? x_in : (const float*)out)


    for (int ph = lo; ph < hi; ++ph) {
        const int l = ph / 13, k = ph - 13 * l;
        int tid = threadIdx.x; asm volatile("" : "+v"(tid));
        const int lane = tid & 63, wave = __builtin_amdgcn_readfirstlane(tid >> 6);
        const int gw = bx * NWAVES + wave, NGW = G * NWAVES; const long gt = (long)bx * NTHR + tid, NGT = (long)G * NTHR;
        unsigned char* const ws = (unsigned char*)TABP(20);
        (void)lane; (void)gw; (void)NGW; (void)gt; (void)NGT;
        if (k == 1 || k == 7 || k == 9) {
            const int hf = (k == 9);
            pg8::Gemm g; pg8::StaticOrder S; pg8::EpiBf16<0> E;
            if (k == 1) { g = pg8::Gemm{HN, Win_t, M, NPROJ, D}; S.init(M, NPROJ, G, bx); E = pg8::EpiBf16<0>{PROJ, NPROJ, nullptr, 0, 0, 1.f}; }
            else { g = pg8::Gemm{HN2 + (size_t)hf * MH * D, Wgu_t, MH, NGU, D}; S.init(MH, NGU, G, bx); E = pg8::EpiBf16<0>{GU, NGU, nullptr, 0, 0, 1.f}; }
            pg8::gemm_phase<pg8::EpiBf16<0>, pg8::StaticOrder, true, true>(lds, g, S, E);
        } else if (k == 5 || k == 11) {
            pg8::Gemm g; pg8::StaticOrder S; pg8::EpiF32 E;
            if (k == 5) { g = pg8::Gemm{YB, Wout_t, M, D, D}; E = pg8::EpiF32{MIX, D, nullptr}; }
            else { g = pg8::Gemm{ACT, Wdn_t, M, D, DFF}; E = pg8::EpiF32{FF, D, nullptr}; }
            S.init(M, D, G, bx);
            pg8::gemm_phase<pg8::EpiF32, pg8::StaticOrder, true, true>(lds, g, S, E);
        } else if (k == 0) {
        {
            LAS float* scr = (LAS float*)(lds + wave * 16384);
            constexpr int I_IN = 16 * (NPROJ / 32), I_OUT = 16 * (D / 32);
            for (int it = gw; it < I_IN + I_OUT; it += NGW) {
                int r = it;
                if (r < I_IN) { const int kb = r / (NPROJ / 32), db = r % (NPROJ / 32), d = 32 * db + (lane & 31);
                    const int src = d < 1536 ? d : d < 3072 ? d + 16 : d < 3088 ? d - 1536 : d < 3120 ? d : -1;
                    tr_item(w_in, INC, src, 64 * kb, Win_t, D, 32 * db, scr, lane); continue; }
                r -= I_IN;
                { const int kb = r / (D / 32), db = r % (D / 32); tr_item(w_out, D, 32 * db + (lane & 31), 64 * kb, Wout_t, D, 32 * db, scr, lane); }
            }
            if (bx == 0) for (int e = tid; e < 1024; e += NTHR) ((unsigned*)(ws + WS_ONES))[e] = 0x3F803F80u;
            for (int m = gw; m < M; m += NGW) {
                const float4* xr = (const float4*)(xcur + (size_t)m * D) + lane; const float4* gr = (const float4*)g_mix_pre + lane;
                float4 v[4]; float s = 0.f;
#pragma unroll
                for (int j = 0; j < 4; ++j) { v[j] = xr[64 * j]; s += (v[j].x * v[j].x + v[j].y * v[j].y) + (v[j].z * v[j].z + v[j].w * v[j].w); }
                const float r = 1.f / sqrtf(wave_sum(s) * (1.f / D) + EPS);
                unsigned long long* o8 = (unsigned long long*)(HN + (size_t)m * D) + lane;
#pragma unroll
                for (int j = 0; j < 4; ++j) { const float4 g = gr[64 * j];
                    o8[64 * j] = (unsigned long long)pk2(v[j].x * r * g.x, v[j].y * r * g.y) | ((unsigned long long)pk2(v[j].z * r * g.z, v[j].w * r * g.w) << 32); }
            }
        }
        } else if (k == 2) {
        for (int u = bx; u < BATCH * NCH; u += G) prep_unit(lds, ws, u, tid, l);
        } else if (k == 3) {
        if (wave < 2 && G == 256) {
            const int x = bx & 7, q = bx >> 3, ls = wave * 32 + q;
            const int gla = ls >> 5, l2 = ls & 31, gx = x * 8 + (l2 >> 2), et = l2 & 3, dir = gx & 1, bh = gx >> 1;
            ScanItem it;
            it.gla = gla; it.bwd = dir; it.wden = (!gla && et == 0);
            const size_t rec8 = (size_t)bh * NCH * 8192;
            if (gla) { it.qf = ws + WS_QFG + (size_t)dir * 32 * NCH * 8192 + rec8; it.kf = ws + WS_KFG + (size_t)dir * 32 * NCH * 8192 + rec8; it.kt = ws + WS_KTG + (size_t)dir * 32 * NCH * 8192 + rec8;
                it.vt = ws + WS_VTG + (size_t)bh * NCH * 16384 + et * 4096; it.aux = ws + WS_AUXG + (size_t)((bh * 2 + dir) * NCH) * 1024; }
            else { it.qf = ws + WS_QFM + rec8; it.kf = ws + WS_KFM + rec8; it.kt = ws + WS_KTM + rec8;
                it.vt = ws + WS_VTM + (size_t)bh * NCH * 16384 + et * 4096; it.aux = ws + WS_AUXM + (size_t)((bh * 2 + dir) * NCH) * 2048; }
            it.ht = (bf16*)(ws + WS_HT) + ((size_t)(dir * BATCH + (bh >> 2)) * D + gla * 512 + (bh & 3) * 128 + 32 * et) * SEQ;
            it.den = (float*)(ws + WS_DEN) + (size_t)(bh * 2 + dir) * SEQ;
            LAS unsigned char* sl = lds + wave * SLOT_BYTES; LAS float* scr = (LAS float*)(lds + SCR_OFF + wave * 2048);
            if (gla) scan_wave<true, false>(sl, scr, it, lane);
            else if (it.wden) scan_wave<false, true>(sl, scr, it, lane);
            else scan_wave<false, false>(sl, scr, it, lane);
        }
        } else if (k == 4) {
        for (int u = bx; u < BATCH * NCH; u += G) {
            const int b = u >> 5, c = u & 31, hs = wave, tl = lane, t = c * 64 + tl;
            LAS bf16* ys = (LAS bf16*)lds;
            const bf16* HFt = (const bf16*)(ws + WS_HT) + ((size_t)(0 * BATCH + b) * D + hs * 128) * SEQ + t;
            const bf16* HBt = (const bf16*)(ws + WS_HT) + ((size_t)(1 * BATCH + b) * D + hs * 128) * SEQ + t;
            float df = 1.f, db = 1.f;
            if (hs < 4) { df = 1.f / ((const float*)(ws + WS_DEN))[(size_t)((b * 4 + hs) * 2 + 0) * SEQ + t]; db = 1.f / ((const float*)(ws + WS_DEN))[(size_t)((b * 4 + hs) * 2 + 1) * SEQ + t]; }
            float ss = 0.f;
            for (int e = 0; e < 128; ++e) { const float h = bf2f(HFt[(size_t)e * SEQ]) * df + bf2f(HBt[(size_t)e * SEQ]) * db; ss += h * h; }
            const float rn = 1.f / sqrtf(ss * (1.f / 128.f) + EPS);
            const float* nw = hs < 4 ? mnorm + hs * 128 : gnorm + (hs - 4) * 128;
            __syncthreads();
            for (int e = 0; e < 128; ++e) { const float h = bf2f(HFt[(size_t)e * SEQ]) * df + bf2f(HBt[(size_t)e * SEQ]) * db;
                ys[tl * 1032 + hs * 128 + e] = (bf16)f2bf(h * rn * nw[e]); }
            __syncthreads();
            for (int idx = tid; idx < 64 * 128; idx += NTHR) { const int t2 = idx >> 7, c8 = (idx & 127) * 8;
                const v4u yv = *(const LAS v4u*)(ys + t2 * 1032 + c8); const v4u gv = *(const v4u*)((const bf16*)(ws + WS_GATES) + (size_t)(b * SEQ + c * 64 + t2) * D + c8);
                v4u o; o.x = pk2(bflo(yv.x) * bflo(gv.x), bfhi(yv.x) * bfhi(gv.x)); o.y = pk2(bflo(yv.y) * bflo(gv.y), bfhi(yv.y) * bfhi(gv.y));
                o.z = pk2(bflo(yv.z) * bflo(gv.z), bfhi(yv.z) * bfhi(gv.z)); o.w = pk2(bflo(yv.w) * bflo(gv.w), bfhi(yv.w) * bfhi(gv.w));
                *(v4u*)(YB + (size_t)(b * SEQ + c * 64 + t2) * D + c8) = o; }
        }
        } else if (k == 6) {
        {
            LAS float* scr = (LAS float*)(lds + wave * 16384);
            constexpr int I_GU = 16 * (NGU / 32), I_DN = (DFF / 64) * (D / 32);
            for (int it = gw; it < I_GU + I_DN; it += NGW) {
                int r = it;
                if (r < I_GU) { const int kb = r / (NGU / 32), db = r % (NGU / 32), d = 32 * db + (lane & 31), pn = d >> 8, rr = d & 255, bj = rr >> 7, j = rr & 127;
                    tr_item(bj ? w_up : w_gate, DFF, 128 * pn + j, 64 * kb, Wgu_t, D, 32 * db, scr, lane); continue; }
                r -= I_GU;
                { const int kb = r / (D / 32), db = r % (D / 32); tr_item(w_down, D, 32 * db + (lane & 31), 64 * kb, Wdn_t, DFF, 32 * db, scr, lane); }
            }
            for (int m = gw; m < M; m += NGW) {
                const float4* mr = (const float4*)(MIX + (size_t)m * D) + lane; const float4* xr = (const float4*)(xcur + (size_t)m * D) + lane;
                const float4* g1 = (const float4*)g_mix_post + lane; const float4* g2 = (const float4*)g_ffn_pre + lane;
                float4 v[4], xv[4]; float s = 0.f;
#pragma unroll
                for (int j = 0; j < 4; ++j) { v[j] = mr[64 * j]; xv[j] = xr[64 * j]; s += (v[j].x * v[j].x + v[j].y * v[j].y) + (v[j].z * v[j].z + v[j].w * v[j].w); }
                const float r = 1.f / sqrtf(wave_sum(s) * (1.f / D) + EPS); float s2 = 0.f;
#pragma unroll
                for (int j = 0; j < 4; ++j) { const float4 g = g1[64 * j];
                    xv[j].x += v[j].x * r * g.x; xv[j].y += v[j].y * r * g.y; xv[j].z += v[j].z * r * g.z; xv[j].w += v[j].w * r * g.w;
                    s2 += (xv[j].x * xv[j].x + xv[j].y * xv[j].y) + (xv[j].z * xv[j].z + xv[j].w * xv[j].w); }
                const float r2 = 1.f / sqrtf(wave_sum(s2) * (1.f / D) + EPS);
                float4* orow = (float4*)(out + (size_t)m * D) + lane; unsigned long long* o8 = (unsigned long long*)(HN2 + (size_t)m * D) + lane;
#pragma unroll
                for (int j = 0; j < 4; ++j) { const float4 g = g2[64 * j]; orow[64 * j] = xv[j];
                    o8[64 * j] = (unsigned long long)pk2(xv[j].x * r2 * g.x, xv[j].y * r2 * g.y) | ((unsigned long long)pk2(xv[j].z * r2 * g.z, xv[j].w * r2 * g.w) << 32); }
            }
        }
        } else if (k == 8 || k == 10) {
            const int hf = (k == 10);
            for (long idx = gt; idx < (long)MH * DFF; idx += NGT) {
                const int tl = (int)(idx / DFF), c = (int)(idx % DFF), t = hf * MH + tl, s = t & (SEQ - 1);
                const int cg = (c >> 7) * 256 + (c & 127);
                const bf16* P = GU + (size_t)tl * NGU + cg;
                const float gm = s > 0 ? bf2f(P[-NGU]) : 0.f, g0 = bf2f(P[0]), gp = s < SEQ - 1 ? bf2f(P[NGU]) : 0.f, u = bf2f(P[128]);
                const float gc = gm * fconv_w[c] + g0 * fconv_w[DFF + c] + gp * fconv_w[2 * DFF + c] + fconv_b[c];
                ACT[(size_t)t * DFF + c] = (bf16)f2bf(gelu_tanh(gc) * u);
            }
        } else {
        for (int m = gw; m < M; m += NGW) {
            const float4* fr = (const float4*)(FF + (size_t)m * D) + lane; float4* xr = (float4*)(out + (size_t)m * D) + lane;
            const float4* g1 = (const float4*)g_ffn_post + lane;
            float4 v[4]; float s = 0.f;
#pragma unroll
            for (int j = 0; j < 4; ++j) { v[j] = fr[64 * j]; s += (v[j].x * v[j].x + v[j].y * v[j].y) + (v[j].z * v[j].z + v[j].w * v[j].w); }
            const float r = 1.f / sqrtf(wave_sum(s) * (1.f / D) + EPS);
#pragma unroll
            for (int j = 0; j < 4; ++j) { const float4 g = g1[64 * j]; float4 xv = xr[64 * j];
                xv.x += v[j].x * r * g.x; xv.y += v[j].y * r * g.y; xv.z += v[j].z * r * g.z; xv.w += v[j].w * r * g.w; xr[64 * j] = xv; }
        }
        }
        if (ph + 1 < hi) xcd_barrier(bar);
    }
}
#undef x_in
#undef out
#undef Win_t
#undef Wout_t
#undef Wgu_t
#undef Wdn_t
#undef PROJ
#undef GU
#undef FF
#undef HN
#undef HN2
#undef YB
#undef MIX
#undef ACT
#undef g_mix_pre
#undef g_mix_post
#undef g_ffn_pre
#undef g_ffn_post
#undef w_in
#undef mnorm
#undef gnorm
#undef w_out
#undef w_gate
#undef w_up
#undef fconv_w
#undef fconv_b
#undef w_down
#undef xcur

#ifndef MK_PER_PHASE
#define MK_PER_PHASE 0
#endif
constexpr int N_PHASES = DEPTH * 13;

extern "C" void kernel_launch(void* const* d_in, const int* in_sizes, int n_in, void* d_out, int out_size, void* d_ws, size_t ws_size, hipStream_t stream) {
    static int grid = 0;
    if (grid == 0) {
        if (n_in != 19 || in_sizes[0] != M * D || out_size != M * D || ws_size < WS_END) { fprintf(stderr, "kernel_launch: unexpected shapes (n_in %d, in0 %d, out %d, ws %zu)\n", n_in, n_in > 0 ? in_sizes[0] : -1, out_size, ws_size); grid = -1; return; }
        int dev = 0, cus = 0, per_cu = 0;
        if (hipGetDevice(&dev) != hipSuccess || hipDeviceGetAttribute(&cus, hipDeviceAttributeMultiprocessorCount, dev) != hipSuccess) { grid = -1; return; }
        if (hipFuncSetAttribute((const void*)fwd_kernel, hipFuncAttributeMaxDynamicSharedMemorySize, LDS_BYTES) != hipSuccess) { fprintf(stderr, "kernel_launch: hipFuncSetAttribute failed\n"); grid = -1; return; }
        if (hipOccupancyMaxActiveBlocksPerMultiprocessor(&per_cu, (const void*)fwd_kernel, NTHR, LDS_BYTES) != hipSuccess || per_cu < 1) { fprintf(stderr, "kernel_launch: occupancy query says %d\n", per_cu); per_cu = 1; }
        (void)hipGetLastError();
        grid = cus;
    }
    if (grid < 0) return;
    (void)hipMemsetAsync((char*)d_ws + WS_CTL, 0, CTL_ZERO_BYTES, stream);
    Args a{};
    for (int i = 0; i < 19; ++i) a.in[i] = (const float*)d_in[i];
    a.out = (float*)d_out; a.ws = (unsigned char*)d_ws;
#if MK_PER_PHASE
    for (int p = 0; p < N_PHASES; ++p) { a.ph_lo = p; a.ph_hi = p + 1; hipLaunchKernelGGL(fwd_kernel, dim3(grid), dim3(NTHR), LDS_BYTES, stream, a); }
#else
    a.ph_lo = 0; a.ph_hi = N_PHASES;
    hipLaunchKernelGGL(fwd_kernel, dim3(grid), dim3(NTHR), LDS_BYTES, stream, a);
#endif
}
```
